# Optimizing an MI355X kernel written in HIP

```python
import jax, jax.numpy as jnp
from jax import lax
import numpy as np

D_MODEL = 1024
BATCH = 2
SEQ = 8192
DEPTH = 1

D_PLE = 256
EPS = 1e-6

GLA_HEADS = 4
GLA_DK = 64
GLA_DV = 128
GLA_LOWRANK = 16
GLA_TAU = 16.0
GLA_CHUNK = 64
GLA_QK = GLA_HEADS * GLA_DK
GLA_V = GLA_HEADS * GLA_DV

CONV_WIDTH = D_MODEL // 2
CONV_K = 3

D_MIX = GLA_V + CONV_WIDTH

IN_SPLIT_SIZES = (GLA_QK, GLA_QK, GLA_V, GLA_V, GLA_LOWRANK, CONV_WIDTH, CONV_WIDTH, CONV_WIDTH)
D_IN = sum(IN_SPLIT_SIZES)
IN_SPLIT_POINTS = tuple(int(c) for c in np.cumsum(IN_SPLIT_SIZES)[:-1])

N_GROUPS = 4
EXPERTS_PER_GROUP = 4
N_EXPERTS = N_GROUPS * EXPERTS_PER_GROUP
TOP_K = 2
D_EXPERT = D_MODEL // 2

kernel_name = "hymba_gla_shortconv_hiermoe_ple"


def rms_norm(x, g):
    xf = x.astype(jnp.float32)
    y = xf * lax.rsqrt(jnp.mean(xf * xf, axis=-1, keepdims=True) + EPS)
    return (y * g.astype(jnp.float32)).astype(x.dtype)


def gla_chunked(q, k, v, log_a):
    q, k, v, log_a = (t.astype(jnp.float32) for t in (q, k, v, log_a))
    b, h, s, dk = q.shape
    dv = v.shape[-1]
    n = s // GLA_CHUNK

    def to_chunks(t):
        return jnp.moveaxis(t.reshape(b, h, n, GLA_CHUNK, t.shape[-1]), 2, 0)

    causal = jnp.tril(jnp.ones((GLA_CHUNK, GLA_CHUNK), dtype=bool))[None, None, :, :, None]

    def step(state, inp):
        qc, kc, vc, ac = inp
        cum = jnp.cumsum(ac, axis=2)
        o_inter = jnp.einsum('bhld,bhde->bhle', qc * jnp.exp(cum), state)
        diff = cum[:, :, :, None, :] - cum[:, :, None, :, :]
        decay = jnp.exp(jnp.where(causal, diff, -jnp.inf))
        scores = jnp.einsum('bhtd,bhsd,bhtsd->bhts', qc, kc, decay)
        o_intra = jnp.einsum('bhts,bhse->bhte', scores, vc)
        last = cum[:, :, -1:, :]
        k_dec = kc * jnp.exp(last - cum)
        new_state = jnp.exp(last[:, :, 0, :])[..., None] * state + jnp.einsum('bhld,bhle->bhde', k_dec, vc)
        return new_state, o_inter + o_intra

    state0 = jnp.zeros((b, h, dk, dv), jnp.float32)
    _, out = lax.scan(step, state0, (to_chunks(q), to_chunks(k), to_chunks(v), to_chunks(log_a)))
    return jnp.moveaxis(out, 0, 2).reshape(b, h, s, dv)


def causal_depthwise_conv(u, w):
    return lax.conv_general_dilated(
        u, w[:, None, :].astype(u.dtype), window_strides=(1,),
        padding=[(CONV_K - 1, 0)], dimension_numbers=('NWC', 'WIO', 'NWC'),
        feature_group_count=u.shape[-1])


def hybrid_mixer(h, w_in, w_gla_gate, b_gla_gate, g_gla_out, w_conv, w_out):
    b, s, _ = h.shape
    proj = h @ w_in
    q, k, v, g, a_low, conv_b, conv_c, conv_u = jnp.split(proj, IN_SPLIT_POINTS, axis=-1)

    def heads(t, d):
        return t.reshape(b, s, GLA_HEADS, d).transpose(0, 2, 1, 3)

    log_a = jax.nn.log_sigmoid((a_low @ w_gla_gate + b_gla_gate).astype(jnp.float32)) / GLA_TAU
    o = gla_chunked(heads(q, GLA_DK) * (GLA_DK ** -0.5), heads(k, GLA_DK),
                    heads(v, GLA_DV), heads(log_a, GLA_DK))
    o = rms_norm(o, g_gla_out).astype(h.dtype)
    y_gla = o.transpose(0, 2, 1, 3).reshape(b, s, GLA_V) * jax.nn.silu(g)

    y_conv = conv_b * causal_depthwise_conv(conv_c * conv_u, w_conv)

    return jnp.concatenate([y_gla, y_conv], axis=-1) @ w_out


def hier_moe(h, w_group, b_group, w_router, b_router, w_gate, w_up, w_down):
    b, s, d = h.shape
    t = h.reshape(b * s, d)
    n_tok = t.shape[0]
    group_logits = (t @ w_group + b_group).astype(jnp.float32)
    group_prob = jax.nn.softmax(group_logits, axis=-1)
    p_grp, g_sel = lax.top_k(group_prob, 1)
    exp_logits = (t @ w_router + b_router).astype(jnp.float32).reshape(n_tok, N_GROUPS, EXPERTS_PER_GROUP)
    in_group = jnp.take_along_axis(exp_logits, g_sel[:, :, None], axis=1)[:, 0]
    top_p, top_i = lax.top_k(jax.nn.softmax(in_group, axis=-1), TOP_K)
    weights = p_grp * top_p / jnp.sum(top_p, axis=-1, keepdims=True)
    expert_id = g_sel * EXPERTS_PER_GROUP + top_i
    combine = jnp.einsum('tke,tk->te', jax.nn.one_hot(expert_id, N_EXPERTS, dtype=jnp.float32), weights).astype(t.dtype)
    y = jnp.zeros_like(t)
    for e in range(N_EXPERTS):
        hid = jax.nn.silu(t @ w_gate[e]) * (t @ w_up[e])
        y = y + combine[:, e:e + 1] * (hid @ w_down[e])
    return y.reshape(b, s, d)


def setup_inputs(seed: int = 0) -> dict:
    key = jax.random.key(seed)
    ks = jax.random.split(key, 24)
    f32 = jnp.float32

    def nrm(k, shape, scale):
        return jax.random.normal(k, shape, f32) * scale

    def gain(k, shape):
        return 1.0 + 0.02 * jax.random.normal(k, shape, f32)

    L = DEPTH
    return {
        "x": nrm(ks[0], (BATCH, SEQ, D_MODEL), 1.0),
        "p": nrm(ks[1], (DEPTH, BATCH, SEQ, D_PLE), 1.0),
        "g_mix": gain(ks[2], (L, D_MODEL)),
        "w_in": nrm(ks[3], (L, D_MODEL, D_IN), D_MODEL ** -0.5),
        "w_gla_gate": nrm(ks[4], (L, GLA_LOWRANK, GLA_QK), GLA_LOWRANK ** -0.5),
        "b_gla_gate": nrm(ks[5], (L, GLA_QK), 0.1),
        "g_gla_out": gain(ks[6], (L, GLA_DV)),
        "w_conv": nrm(ks[7], (L, CONV_K, CONV_WIDTH), CONV_K ** -0.5),
        "w_out": nrm(ks[8], (L, D_MIX, D_MODEL), D_MIX ** -0.5),
        "g_moe": gain(ks[9], (L, D_MODEL)),
        "w_group": nrm(ks[10], (L, D_MODEL, N_GROUPS), D_MODEL ** -0.5),
        "b_group": nrm(ks[11], (L, N_GROUPS), 0.01),
        "w_router": nrm(ks[12], (L, D_MODEL, N_EXPERTS), D_MODEL ** -0.5),
        "b_router": nrm(ks[13], (L, N_EXPERTS), 0.01),
        "w_exp_gate": nrm(ks[14], (L, N_EXPERTS, D_MODEL, D_EXPERT), D_MODEL ** -0.5),
        "w_exp_up": nrm(ks[15], (L, N_EXPERTS, D_MODEL, D_EXPERT), D_MODEL ** -0.5),
        "w_exp_down": nrm(ks[16], (L, N_EXPERTS, D_EXPERT, D_MODEL), D_EXPERT ** -0.5),
        "g_ple": gain(ks[17], (L, D_MODEL)),
        "w_ple_gate": nrm(ks[18], (L, D_MODEL, D_MODEL), D_MODEL ** -0.5),
        "w_ple_proj": nrm(ks[19], (L, D_PLE, D_MODEL), D_PLE ** -0.5),
        "g_final": gain(ks[20], (D_MODEL,)),
    }


def reference(x, p, g_mix, w_in, w_gla_gate, b_gla_gate, g_gla_out, w_conv, w_out,
              g_moe, w_group, b_group, w_router, b_router, w_exp_gate, w_exp_up, w_exp_down,
              g_ple, w_ple_gate, w_ple_proj, g_final):
    for i in range(DEPTH):
        h = rms_norm(x, g_mix[i])
        x = x + hybrid_mixer(h, w_in[i], w_gla_gate[i], b_gla_gate[i], g_gla_out[i], w_conv[i], w_out[i])
        h = rms_norm(x, g_moe[i])
        x = x + hier_moe(h, w_group[i], b_group[i], w_router[i], b_router[i],
                         w_exp_gate[i], w_exp_up[i], w_exp_down[i])
        gate = jax.nn.sigmoid(rms_norm(x, g_ple[i]) @ w_ple_gate[i])
        x = x + gate * (p[i] @ w_ple_proj[i])
    return rms_norm(x, g_final)
```

```cpp
#include <hip/hip_runtime.h>
#include <cstdio>
#include <cstdint>

typedef unsigned short bf16_t;
typedef short bf16x8 __attribute__((ext_vector_type(8)));
typedef float f32x4 __attribute__((ext_vector_type(4)));
typedef unsigned u32x4 __attribute__((ext_vector_type(4)));
typedef unsigned u32x2 __attribute__((ext_vector_type(2)));

constexpr int D = 1024, NB = 2, S = 8192, T = NB * S, DPLE = 256;
constexpr int H = 4, DK = 64, DV = 128, LR = 16, QK = 256, GV = 512, CW = 512;
constexpr int DIN = 3088, NPROJ = 3072;
constexpr int NE = 16, DE = 512, NCAT = 24;
constexpr float EPS = 1e-6f;
constexpr int PQ = 0, PK = 256, PV = 512, PG = 1024, PB = 1536, PC = 2048, PU = 2560;
constexpr int MAXRT = 88;

constexpr size_t MiB = 1u << 20;
constexpr size_t WS_CTL = 0;
constexpr size_t WS_WIN = 1 * MiB;
constexpr size_t WS_WOUT = 7 * MiB;
constexpr size_t WS_WPG = 9 * MiB;
constexpr size_t WS_WPP = 11 * MiB;
constexpr size_t WS_WA = 11 * MiB + 512 * 1024;
constexpr size_t WS_WR = 11 * MiB + 768 * 1024;
constexpr size_t WS_W1 = 12 * MiB;
constexpr size_t WS_W2 = 44 * MiB;
constexpr size_t WS_SMALL = 60 * MiB;
constexpr size_t WS_RSTD1 = WS_SMALL;
constexpr size_t WS_ALOW = WS_SMALL + 64 * 1024;
constexpr size_t WS_SSQ2 = WS_ALOW + 1 * MiB;
constexpr size_t WS_SSQ3 = WS_SSQ2 + 64 * 1024;
constexpr size_t WS_SSQ4 = WS_SSQ3 + 64 * 1024;
constexpr size_t WS_TOKI = WS_SSQ4 + 64 * 1024;
constexpr size_t WS_LIST = WS_TOKI + 256 * 1024;
constexpr size_t WS_RB = 64 * MiB;
constexpr size_t WS_PB = 96 * MiB;
constexpr size_t WS_PROJ = 104 * MiB;
constexpr size_t WS_HID = WS_PROJ;
constexpr size_t WS_X2 = WS_PROJ + 44 * MiB;
constexpr size_t WS_Y = 200 * MiB;
constexpr size_t WS_OBUF = 232 * MiB;
constexpr size_t WS_END = 256 * MiB;

struct TokInfo { int cat; float w_lo, w_hi, rstd; };

__device__ __forceinline__ float bf2f(bf16_t v) { return __uint_as_float(((unsigned)v) << 16); }
__device__ __forceinline__ bf16_t f2bf(float f) { unsigned u = __float_as_uint(f); return (bf16_t)((u + 0x7fffu + ((u >> 16) & 1u)) >> 16); }
__device__ __forceinline__ unsigned pk2(float lo, float hi) { return (unsigned)f2bf(lo) | ((unsigned)f2bf(hi) << 16); }
__device__ __forceinline__ float wave_sum(float v) {
#pragma unroll
    for (int o = 1; o < 64; o <<= 1) v += __shfl_xor(v, o);
    return v;
}
__device__ __forceinline__ float sigmoidf_(float x) { return 1.0f / (1.0f + __expf(-x)); }
__device__ __forceinline__ float siluf_(float x) { return x * sigmoidf_(x); }
__device__ __forceinline__ float logsigmoidf_(float x) { return fminf(x, 0.f) - log1pf(__expf(-fabsf(x))); }

struct Ptrs {
    const float *x, *p, *g_mix, *w_in, *w_gla_gate, *b_gla_gate, *g_gla_out, *w_conv, *w_out, *g_moe, *w_group, *b_group, *w_router, *b_router,
        *w_exp_gate, *w_exp_up, *w_exp_down, *g_ple, *w_ple_gate, *w_ple_proj, *g_final;
    float* out; unsigned char* ws;
};

struct WJob { const float* src; int src_ld; const float* gain; bf16_t* dst; int dst_ld; int K, N; int mode; };
constexpr int NJOBS = 5 + 32 + 16;
__device__ __forceinline__ WJob get_job(const Ptrs& P, int j) {
    WJob w;
    if (j == 0) { w = WJob{P.w_in, DIN, P.g_mix, (bf16_t*)(P.ws + WS_WIN), D, D, NPROJ, 1}; }
    else if (j == 1) { w = WJob{P.w_in + 1536, DIN, P.g_mix, (bf16_t*)(P.ws + WS_WA), D, D, LR, 0}; }
    else if (j == 2) { w = WJob{P.w_out, D, nullptr, (bf16_t*)(P.ws + WS_WOUT), D, D, D, 0}; }
    else if (j == 3) { w = WJob{P.w_ple_gate, D, P.g_ple, (bf16_t*)(P.ws + WS_WPG), D, D, D, 0}; }
    else if (j == 4) { w = WJob{P.w_ple_proj, D, nullptr, (bf16_t*)(P.ws + WS_WPP), DPLE, DPLE, D, 0}; }
    else if (j < 37) { const int jj = j - 5, e = jj >> 1, half = jj & 1;
        w = WJob{(half ? P.w_exp_up : P.w_exp_gate) + (size_t)e * D * DE, DE, P.g_moe, (bf16_t*)(P.ws + WS_W1) + (size_t)e * D * D, D, D, DE, 2 + half}; }
    else { const int e = j - 37, g = e >> 2, el = e & 3;
        w = WJob{P.w_exp_down + (size_t)e * DE * D, D, nullptr, (bf16_t*)(P.ws + WS_W2) + (size_t)g * D * 2048 + el * DE, 2048, DE, D, 0}; }
    return w;
}
__device__ __forceinline__ int job_tiles(const WJob& w) { return ((w.N + 31) / 32) * (w.K / 32); }
__device__ __forceinline__ void transpose_tile(const WJob& w, int tile, float* tl, int tid) {
    const int nkt = w.K / 32, nt = tile / nkt, kt = tile % nkt, n0 = nt * 32, k0 = kt * 32;
    const int tx = tid & 31, ty = tid >> 5;
#pragma unroll
    for (int i = 0; i < 4; ++i) { const int kk = ty + 8 * i, n = n0 + tx; float v = 0.f;
        if (n < w.N) { const int col = (w.mode == 1) ? (n < 1536 ? n : n + 16) : n; v = w.src[(size_t)(k0 + kk) * w.src_ld + col]; if (w.gain) v *= w.gain[k0 + kk]; }
        tl[kk * 33 + tx] = v; }
    __syncthreads();
#pragma unroll
    for (int i = 0; i < 4; ++i) { const int nn = ty + 8 * i, n = n0 + nn;
        if (n < w.N) { const int row = (w.mode >= 2) ? (((n >> 7) << 8) + (w.mode - 2) * 128 + (n & 127)) : n;
            w.dst[(size_t)row * w.dst_ld + k0 + tx] = f2bf(tl[tx * 33 + nn]); } }
    __syncthreads();
}
__global__ void __launch_bounds__(256) k_prep_weights(Ptrs P) {
    __shared__ float tl[32 * 33];
    const int tid = threadIdx.x;
    int base = 0;
    for (int j = 0; j < NJOBS; ++j) { const WJob w = get_job(P, j); const int nt = job_tiles(w);
        int first = ((int)blockIdx.x - base % (int)gridDim.x + (int)gridDim.x) % (int)gridDim.x;
        for (int t = first; t < nt; t += gridDim.x) transpose_tile(w, t, tl, tid);
        base += nt; }
    float* WR = (float*)(P.ws + WS_WR);
    for (int i = blockIdx.x * 256 + tid; i < 20 * D; i += gridDim.x * 256) { const int j = i / D, k = i % D;
        WR[i] = P.g_moe[k] * (j < 4 ? P.w_group[k * 4 + j] : P.w_router[k * NE + (j - 4)]); }
}

__global__ void __launch_bounds__(256) k_xprep(Ptrs P) {
    const int lane = threadIdx.x & 63, gw = (blockIdx.x * 256 + threadIdx.x) >> 6, ngw = gridDim.x * 4;
    bf16_t* xb = (bf16_t*)(P.ws + WS_RB); float* rstd1 = (float*)(P.ws + WS_RSTD1); bf16_t* pb = (bf16_t*)(P.ws + WS_PB);
    for (int m = gw; m < T; m += ngw) {
        const f32x4* xr = (const f32x4*)(P.x + (size_t)m * D) + lane; f32x4 v[4]; float s = 0.f;
#pragma unroll
        for (int j = 0; j < 4; ++j) { v[j] = xr[64 * j]; s += (v[j].x * v[j].x + v[j].y * v[j].y) + (v[j].z * v[j].z + v[j].w * v[j].w); }
        s = wave_sum(s);
        if (lane == 0) rstd1[m] = rsqrtf(s * (1.f / D) + EPS);
        u32x2* o = (u32x2*)(xb + (size_t)m * D) + lane;
#pragma unroll
        for (int j = 0; j < 4; ++j) { u32x2 w; w.x = pk2(v[j].x, v[j].y); w.y = pk2(v[j].z, v[j].w); o[64 * j] = w; }
        const f32x4 pv = ((const f32x4*)(P.p + (size_t)m * DPLE))[lane]; u32x2 w; w.x = pk2(pv.x, pv.y); w.y = pk2(pv.z, pv.w);
        ((u32x2*)(pb + (size_t)m * DPLE))[lane] = w;
    }
}

template <class AF, class BF, class Epi, bool DUAL>
__device__ __forceinline__ void sgemm_tile(int m0, int n0, int K, const AF& af, const BF& bf, const Epi& epi, bf16_t* sA, bf16_t* sB, bf16_t* sB2) {
    const int tid = threadIdx.x, lane = tid & 63, wid = tid >> 6, wr = wid >> 1, wc = wid & 1, fr = lane & 15, fq = lane >> 4;
    f32x4 acc[2][2], acc2[2][2];
#pragma unroll
    for (int i = 0; i < 2; ++i)
#pragma unroll
        for (int j = 0; j < 2; ++j) { acc[i][j] = (f32x4){0.f, 0.f, 0.f, 0.f}; acc2[i][j] = (f32x4){0.f, 0.f, 0.f, 0.f}; }
    const int lr = tid >> 2, lc = (tid & 3) * 8;
    const bf16_t* ap = af(m0 + lr);
    for (int k0 = 0; k0 < K; k0 += 32) {
        u32x4 va = (u32x4){0u, 0u, 0u, 0u}; if (ap) va = *(const u32x4*)(ap + k0 + lc);
        const u32x4 vb = *(const u32x4*)(bf(n0 + lr, 0, k0) + lc);
        *(u32x4*)(sA + lr * 40 + lc) = va; *(u32x4*)(sB + lr * 40 + lc) = vb;
        if (DUAL) { const u32x4 vb2 = *(const u32x4*)(bf(n0 + lr, 1, k0) + lc); *(u32x4*)(sB2 + lr * 40 + lc) = vb2; }
        __syncthreads();
        bf16x8 a[2], b[2], b2[2];
#pragma unroll
        for (int i = 0; i < 2; ++i) a[i] = *(const bf16x8*)(sA + (wr * 32 + i * 16 + fr) * 40 + fq * 8);
#pragma unroll
        for (int j = 0; j < 2; ++j) { b[j] = *(const bf16x8*)(sB + (wc * 32 + j * 16 + fr) * 40 + fq * 8); if (DUAL) b2[j] = *(const bf16x8*)(sB2 + (wc * 32 + j * 16 + fr) * 40 + fq * 8); }
#pragma unroll
        for (int i = 0; i < 2; ++i)
#pragma unroll
            for (int j = 0; j < 2; ++j) { acc[i][j] = __builtin_amdgcn_mfma_f32_16x16x32_bf16(a[i], b[j], acc[i][j], 0, 0, 0);
                if (DUAL) acc2[i][j] = __builtin_amdgcn_mfma_f32_16x16x32_bf16(a[i], b2[j], acc2[i][j], 0, 0, 0); }
        __syncthreads();
    }
#pragma unroll
    for (int i = 0; i < 2; ++i)
#pragma unroll
        for (int j = 0; j < 2; ++j)
#pragma unroll
            for (int r = 0; r < 4; ++r) epi(m0 + wr * 32 + i * 16 + 4 * fq + r, n0 + wc * 32 + j * 16 + fr, acc[i][j][r], acc2[i][j][r]);
}

struct AFPlain { const bf16_t* A; int lda; __device__ const bf16_t* operator()(int m) const { return A + (size_t)m * lda; } };
struct BFPlain { const bf16_t* Bt; int ldb; __device__ const bf16_t* operator()(int n, int, int k0) const { return Bt + (size_t)n * ldb + k0; } };
struct EpiProj { bf16_t* proj; const float* rstd; __device__ void operator()(int m, int n, float v, float) const { float s = rstd[m]; if (n < 256) s *= 0.125f; proj[(size_t)m * NPROJ + n] = f2bf(v * s); } };
__global__ void __launch_bounds__(256) k_inproj(Ptrs P) {
    __shared__ __attribute__((aligned(16))) bf16_t sA[64 * 40], sB[64 * 40];
    AFPlain af{(const bf16_t*)(P.ws + WS_RB), D}; BFPlain bf{(const bf16_t*)(P.ws + WS_WIN), D}; EpiProj ep{(bf16_t*)(P.ws + WS_PROJ), (const float*)(P.ws + WS_RSTD1)};
    sgemm_tile<AFPlain, BFPlain, EpiProj, false>(blockIdx.y * 64, blockIdx.x * 64, D, af, bf, ep, sA, sB, sB);
}
__global__ void __launch_bounds__(256) k_alow(Ptrs P) {
    const int lane = threadIdx.x & 63, gw = (blockIdx.x * 256 + threadIdx.x) >> 6, ngw = gridDim.x * 4;
    const bf16_t* xb = (const bf16_t*)(P.ws + WS_RB); const bf16_t* wa = (const bf16_t*)(P.ws + WS_WA); const float* rstd1 = (const float*)(P.ws + WS_RSTD1); float* alow = (float*)(P.ws + WS_ALOW);
    for (int m = gw; m < T; m += ngw) {
        float acc[LR];
#pragma unroll
        for (int j = 0; j < LR; ++j) acc[j] = 0.f;
        for (int k = lane; k < D; k += 64) { const float xv = bf2f(xb[(size_t)m * D + k]);
#pragma unroll
            for (int j = 0; j < LR; ++j) acc[j] += xv * bf2f(wa[j * D + k]); }
#pragma unroll
        for (int j = 0; j < LR; ++j) { const float s = wave_sum(acc[j]); if (lane == j) alow[(size_t)m * LR + j] = s * rstd1[m]; }
    }
}

__global__ void __launch_bounds__(512) k_gla_naive(Ptrs P) {
    const int lane = threadIdx.x & 63, wid = threadIdx.x >> 6;
    const int bh = blockIdx.x >> 4, sl = blockIdx.x & 15, b = bh >> 2, h = bh & 3, e = sl * 8 + wid;
    const bf16_t* proj = (const bf16_t*)(P.ws + WS_PROJ); const float* alow = (const float*)(P.ws + WS_ALOW); float* obuf = (float*)(P.ws + WS_RB);
    float wg[LR];
#pragma unroll
    for (int r = 0; r < LR; ++r) wg[r] = P.w_gla_gate[r * QK + h * DK + lane];
    const float bg = P.b_gla_gate[h * DK + lane];
    float st = 0.f;
    for (int t = 0; t < S; ++t) {
        const size_t m = (size_t)b * S + t;
        float z = bg;
#pragma unroll
        for (int r = 0; r < LR; ++r) z += alow[m * LR + r] * wg[r];
        const float a = __expf(logsigmoidf_(z) * (1.f / 16.f));
        const float kv = bf2f(proj[m * NPROJ + PK + h * DK + lane]), qv = bf2f(proj[m * NPROJ + PQ + h * DK + lane]), vv = bf2f(proj[m * NPROJ + PV + h * DV + e]);
        st = a * st + kv * vv;
        const float o = wave_sum(qv * st);
        if (lane == 0) obuf[m * GV + h * DV + e] = o;
    }
}
__global__ void __launch_bounds__(256) k_mix_post(Ptrs P) {
    const int lane = threadIdx.x & 63, gw = (blockIdx.x * 256 + threadIdx.x) >> 6, ngw = gridDim.x * 4;
    const bf16_t* proj = (const bf16_t*)(P.ws + WS_PROJ); const float* obuf = (const float*)(P.ws + WS_RB); bf16_t* y = (bf16_t*)(P.ws + WS_Y);
    for (int m = gw; m < T; m += ngw) {
#pragma unroll
        for (int h = 0; h < H; ++h) {
            const float o0 = obuf[(size_t)m * GV + h * DV + lane], o1 = obuf[(size_t)m * GV + h * DV + 64 + lane];
            const float ss = wave_sum(o0 * o0 + o1 * o1), r = rsqrtf(ss * (1.f / DV) + EPS);
            const float g0 = bf2f(proj[(size_t)m * NPROJ + PG + h * DV + lane]), g1 = bf2f(proj[(size_t)m * NPROJ + PG + h * DV + 64 + lane]);
            y[(size_t)m * D + h * DV + lane] = f2bf(o0 * r * P.g_gla_out[lane] * siluf_(g0));
            y[(size_t)m * D + h * DV + 64 + lane] = f2bf(o1 * r * P.g_gla_out[64 + lane] * siluf_(g1));
        }
        const int t = m % S;
        for (int c = lane; c < CW; c += 64) {
            float acc = 0.f;
#pragma unroll
            for (int j = 0; j < 3; ++j) { const int tt = t - 2 + j; if (tt >= 0) { const size_t mm = (size_t)m - 2 + j;
                acc += P.w_conv[j * CW + c] * (bf2f(proj[mm * NPROJ + PC + c]) * bf2f(proj[mm * NPROJ + PU + c])); } }
            y[(size_t)m * D + GV + c] = f2bf(bf2f(proj[(size_t)m * NPROJ + PB + c]) * acc);
        }
    }
}

struct EpiOut { const float* x; bf16_t* x1; float* ssq; __device__ void operator()(int m, int n, float v, float) const { const float r = x[(size_t)m * D + n] + v; x1[(size_t)m * D + n] = f2bf(r); atomicAdd(ssq + m, r * r); } };
__global__ void __launch_bounds__(256) k_outproj(Ptrs P) {
    __shared__ __attribute__((aligned(16))) bf16_t sA[64 * 40], sB[64 * 40];
    AFPlain af{(const bf16_t*)(P.ws + WS_Y), D}; BFPlain bf{(const bf16_t*)(P.ws + WS_WOUT), D}; EpiOut ep{P.x, (bf16_t*)(P.ws + WS_RB), (float*)(P.ws + WS_SSQ2)};
    sgemm_tile<AFPlain, BFPlain, EpiOut, false>(blockIdx.y * 64, blockIdx.x * 64, D, af, bf, ep, sA, sB, sB);
}

__global__ void __launch_bounds__(256) k_route(Ptrs P) {
    const int lane = threadIdx.x & 63, gw = (blockIdx.x * 256 + threadIdx.x) >> 6, ngw = gridDim.x * 4;
    const bf16_t* x1 = (const bf16_t*)(P.ws + WS_RB); const float* WR = (const float*)(P.ws + WS_WR); const float* ssq2 = (const float*)(P.ws + WS_SSQ2);
    TokInfo* ti = (TokInfo*)(P.ws + WS_TOKI); int* lists = (int*)(P.ws + WS_LIST); unsigned* cnt = (unsigned*)(P.ws + WS_CTL);
    for (int m = gw; m < T; m += ngw) {
        float acc[20];
#pragma unroll
        for (int j = 0; j < 20; ++j) acc[j] = 0.f;
        for (int k = lane; k < D; k += 64) { const float xv = bf2f(x1[(size_t)m * D + k]);
#pragma unroll
            for (int j = 0; j < 20; ++j) acc[j] += xv * WR[j * D + k]; }
#pragma unroll
        for (int j = 0; j < 20; ++j) acc[j] = wave_sum(acc[j]);
        if (lane == 0) {
            const float rstd = rsqrtf(ssq2[m] * (1.f / D) + EPS);
            float gl[4]; int gs = 0;
#pragma unroll
            for (int j = 0; j < 4; ++j) gl[j] = acc[j] * rstd + P.b_group[j];
            float gbest = gl[0];
#pragma unroll
            for (int j = 1; j < 4; ++j) if (gl[j] > gbest) { gbest = gl[j]; gs = j; }
            float den = 0.f;
#pragma unroll
            for (int j = 0; j < 4; ++j) den += __expf(gl[j] - gbest);
            const float pgrp = 1.f / den;
            float el[4];
#pragma unroll
            for (int j = 0; j < 4; ++j) { float v = 0.f;
#pragma unroll
                for (int g = 0; g < 4; ++g) if (g == gs) v = acc[4 + g * 4 + j] * rstd + P.b_router[g * 4 + j];
                el[j] = v; }
            int i0 = 0; float v0 = el[0];
#pragma unroll
            for (int j = 1; j < 4; ++j) if (el[j] > v0) { v0 = el[j]; i0 = j; }
            int i1 = -1; float v1 = -3.0e38f;
#pragma unroll
            for (int j = 0; j < 4; ++j) if (j != i0 && el[j] > v1) { v1 = el[j]; i1 = j; }
            const float e1 = __expf(v1 - v0);
            const float w0 = pgrp / (1.f + e1), w1 = pgrp * e1 / (1.f + e1);
            const int lo = i0 < i1 ? i0 : i1, hi = i0 < i1 ? i1 : i0;
            const int pidx = (lo == 0) ? (hi - 1) : (lo == 1 ? (hi + 1) : 5);
            const int cat = gs * 6 + pidx;
            TokInfo info; info.cat = cat; info.w_lo = (i0 < i1) ? w0 : w1; info.w_hi = (i0 < i1) ? w1 : w0; info.rstd = rstd;
            ti[m] = info;
            const unsigned slot = atomicAdd(cnt + cat, 1u);
            lists[(size_t)cat * T + slot] = m;
        }
    }
}
__device__ __forceinline__ void cat_experts(int cat, int& e_lo, int& e_hi) {
    const int g = cat / 6, p = cat % 6; int lo, hi;
    if (p < 3) { lo = 0; hi = p + 1; } else if (p < 5) { lo = 1; hi = p - 1; } else { lo = 2; hi = 3; }
    e_lo = g * 4 + lo; e_hi = g * 4 + hi;
}
__device__ __forceinline__ bool rowtile_lookup(const unsigned* cnt, int rt, int& cat, int& slot0, int& n) {
    int base = 0;
    for (int c = 0; c < NCAT; ++c) { const int nc = (int)cnt[c], ntile = (nc + 255) >> 8; if (rt < base + ntile) { cat = c; slot0 = (rt - base) * 256; n = nc; return true; } base += ntile; }
    return false;
}

struct AFGather { const bf16_t* X; const int* list; int slot0, n; __device__ const bf16_t* operator()(int m) const { const int s = slot0 + (m & 255); return s < n ? X + (size_t)list[s] * D : nullptr; } };
struct BFW1 { const bf16_t* W1; int e_lo, e_hi; __device__ const bf16_t* operator()(int n, int which, int k0) const {
    const int kx = n >> 9, j = n & 511, row = ((j >> 7) << 8) + which * 128 + (j & 127); return W1 + (size_t)(kx ? e_hi : e_lo) * D * D + (size_t)row * D + k0; } };
struct EpiHid { bf16_t* hid; const TokInfo* ti; const int* list; int slot0, n; __device__ void operator()(int m, int nn, float vg, float vu) const {
    const int s = slot0 + (m & 255); float o = 0.f;
    if (s < n) { const TokInfo t = ti[list[s]]; const float w = (nn >> 9) ? t.w_hi : t.w_lo; o = siluf_(vg * t.rstd) * (vu * t.rstd) * w; }
    hid[(size_t)m * D + nn] = f2bf(o); } };
__global__ void __launch_bounds__(256) k_moe1(Ptrs P) {
    __shared__ __attribute__((aligned(16))) bf16_t sA[64 * 40], sB[64 * 40], sB2[64 * 40];
    const unsigned* cnt = (const unsigned*)(P.ws + WS_CTL); const int m0 = blockIdx.y * 64, rt = m0 >> 8; int cat, slot0, n;
    if (!rowtile_lookup(cnt, rt, cat, slot0, n)) return;
    int e_lo, e_hi; cat_experts(cat, e_lo, e_hi);
    const int* list = (const int*)(P.ws + WS_LIST) + (size_t)cat * T;
    AFGather af{(const bf16_t*)(P.ws + WS_RB), list, slot0, n}; BFW1 bf{(const bf16_t*)(P.ws + WS_W1), e_lo, e_hi};
    EpiHid ep{(bf16_t*)(P.ws + WS_HID), (const TokInfo*)(P.ws + WS_TOKI), list, slot0, n};
    sgemm_tile<AFGather, BFW1, EpiHid, true>(m0, blockIdx.x * 64, D, af, bf, ep, sA, sB, sB2);
}
struct BFW2 { const bf16_t* W2g; int el_lo, el_hi; __device__ const bf16_t* operator()(int n, int, int k0) const {
    return W2g + (size_t)n * 2048 + (k0 < 512 ? el_lo * 512 + k0 : el_hi * 512 + (k0 - 512)); } };
struct EpiX2 { const bf16_t* x1; bf16_t* x2; float* ssq; const int* list; int slot0, n; __device__ void operator()(int m, int nn, float v, float) const {
    const int s = slot0 + (m & 255); if (s < n) { const int tok = list[s]; const float r = bf2f(x1[(size_t)tok * D + nn]) + v; x2[(size_t)tok * D + nn] = f2bf(r); atomicAdd(ssq + tok, r * r); } } };
__global__ void __launch_bounds__(256) k_moe2(Ptrs P) {
    __shared__ __attribute__((aligned(16))) bf16_t sA[64 * 40], sB[64 * 40];
    const unsigned* cnt = (const unsigned*)(P.ws + WS_CTL); const int m0 = blockIdx.y * 64, rt = m0 >> 8; int cat, slot0, n;
    if (!rowtile_lookup(cnt, rt, cat, slot0, n)) return;
    int e_lo, e_hi; cat_experts(cat, e_lo, e_hi);
    const int* list = (const int*)(P.ws + WS_LIST) + (size_t)cat * T;
    AFPlain af{(const bf16_t*)(P.ws + WS_HID), D}; BFW2 bf{(const bf16_t*)(P.ws + WS_W2) + (size_t)(cat / 6) * D * 2048, e_lo & 3, e_hi & 3};
    EpiX2 ep{(const bf16_t*)(P.ws + WS_RB), (bf16_t*)(P.ws + WS_X2), (float*)(P.ws + WS_SSQ3), list, slot0, n};
    sgemm_tile<AFPlain, BFW2, EpiX2, false>(m0, blockIdx.x * 64, D, af, bf, ep, sA, sB, sB);
}
struct EpiPP { bf16_t* pp; __device__ void operator()(int m, int n, float v, float) const { pp[(size_t)m * D + n] = f2bf(v); } };
__global__ void __launch_bounds__(256) k_pp(Ptrs P) {
    __shared__ __attribute__((aligned(16))) bf16_t sA[64 * 40], sB[64 * 40];
    AFPlain af{(const bf16_t*)(P.ws + WS_PB), DPLE}; BFPlain bf{(const bf16_t*)(P.ws + WS_WPP), DPLE}; EpiPP ep{(bf16_t*)(P.ws + WS_Y)};
    sgemm_tile<AFPlain, BFPlain, EpiPP, false>(blockIdx.y * 64, blockIdx.x * 64, DPLE, af, bf, ep, sA, sB, sB);
}
struct EpiPle { const bf16_t* x2; const bf16_t* pp; const float* ssq3; bf16_t* x3; float* ssq4; __device__ void operator()(int m, int n, float v, float) const {
    const float rstd = rsqrtf(ssq3[m] * (1.f / D) + EPS); const float r = bf2f(x2[(size_t)m * D + n]) + sigmoidf_(v * rstd) * bf2f(pp[(size_t)m * D + n]);
    x3[(size_t)m * D + n] = f2bf(r); atomicAdd(ssq4 + m, r * r); } };
__global__ void __launch_bounds__(256) k_ple(Ptrs P) {
    __shared__ __attribute__((aligned(16))) bf16_t sA[64 * 40], sB[64 * 40];
    AFPlain af{(const bf16_t*)(P.ws + WS_X2), D}; BFPlain bf{(const bf16_t*)(P.ws + WS_WPG), D};
    EpiPle ep{(const bf16_t*)(P.ws + WS_X2), (const bf16_t*)(P.ws + WS_Y), (const float*)(P.ws + WS_SSQ3), (bf16_t*)(P.ws + WS_RB), (float*)(P.ws + WS_SSQ4)};
    sgemm_tile<AFPlain, BFPlain, EpiPle, false>(blockIdx.y * 64, blockIdx.x * 64, D, af, bf, ep, sA, sB, sB);
}
__global__ void __launch_bounds__(256) k_final(Ptrs P) {
    const int lane = threadIdx.x & 63, gw = (blockIdx.x * 256 + threadIdx.x) >> 6, ngw = gridDim.x * 4;
    const bf16_t* x3 = (const bf16_t*)(P.ws + WS_RB); const float* ssq4 = (const float*)(P.ws + WS_SSQ4);
    for (int m = gw; m < T; m += ngw) {
        const float rstd = rsqrtf(ssq4[m] * (1.f / D) + EPS);
        for (int c = lane; c < D; c += 64) P.out[(size_t)m * D + c] = bf2f(x3[(size_t)m * D + c]) * rstd * P.g_final[c];
    }
}

extern "C" void kernel_launch(void* const* d_in, const int* in_sizes, int n_in, void* d_out, int out_size, void* d_ws, size_t ws_size, hipStream_t stream) {
    if (n_in != 21 || in_sizes[0] != T * D || out_size != T * D || ws_size < WS_END) {
        fprintf(stderr, "kernel_launch: unexpected shapes: n_in %d in0 %d out %d ws %zu\n", n_in, n_in > 0 ? in_sizes[0] : -1, out_size, ws_size); return; }
    Ptrs P{};
    const float** pp = (const float**)&P;
    for (int i = 0; i < 21; ++i) pp[i] = (const float*)d_in[i];
    P.out = (float*)d_out; P.ws = (unsigned char*)d_ws;
    hipMemsetAsync((char*)d_ws + WS_CTL, 0, 1 * MiB, stream);
    hipMemsetAsync((char*)d_ws + WS_SSQ2, 0, 3 * 64 * 1024, stream);
    k_prep_weights<<<1024, 256, 0, stream>>>(P);
    k_xprep<<<1024, 256, 0, stream>>>(P);
    k_inproj<<<dim3(NPROJ / 64, T / 64), 256, 0, stream>>>(P);
    k_alow<<<1024, 256, 0, stream>>>(P);
    k_gla_naive<<<128, 512, 0, stream>>>(P);
    k_mix_post<<<1024, 256, 0, stream>>>(P);
    k_outproj<<<dim3(D / 64, T / 64), 256, 0, stream>>>(P);
    k_route<<<1024, 256, 0, stream>>>(P);
    k_moe1<<<dim3(D / 64, MAXRT * 4), 256, 0, stream>>>(P);
    k_moe2<<<dim3(D / 64, MAXRT * 4), 256, 0, stream>>>(P);
    k_pp<<<dim3(D / 64, T / 64), 256, 0, stream>>>(P);
    k_ple<<<dim3(D / 64, T / 64), 256, 0, stream>>>(P);
    k_final<<<1024, 256, 0, stream>>>(P);
}
```

```cpp
#include <hip/hip_runtime.h>
#include <cstdio>
#include <cstdint>

typedef unsigned short bf16_t;
typedef short bf16x8 __attribute__((ext_vector_type(8)));
typedef float f32x4 __attribute__((ext_vector_type(4)));
typedef unsigned u32x4 __attribute__((ext_vector_type(4)));
typedef unsigned u32x2 __attribute__((ext_vector_type(2)));
#define LAS __attribute__((address_space(3)))

constexpr int D = 1024, NB = 2, S = 8192, T = NB * S, DPLE = 256;
constexpr int H = 4, DK = 64, DV = 128, LR = 16, QK = 256, GV = 512, CW = 512;
constexpr int DIN = 3088, NPROJ = 3072;
constexpr int NE = 16, DE = 512, NCAT = 24;
constexpr float EPS = 1e-6f;
constexpr int PQ = 0, PK = 256, PV = 512, PG = 1024, PB = 1536, PC = 2048, PU = 2560;
constexpr int MAXRT = 88;
constexpr int NTHREADS = 512;

constexpr size_t MiB = 1u << 20;
constexpr size_t WS_CTL = 0, CTL_BYTES = 1 * MiB;
constexpr int CW_BAR = 4096;
constexpr size_t WS_SSQ2 = 256 * 1024;
constexpr size_t WS_SSQ3 = WS_SSQ2 + 64 * 1024;
constexpr size_t WS_SSQ4 = WS_SSQ3 + 64 * 1024;
constexpr size_t WS_WIN = 1 * MiB;
constexpr size_t WS_WOUT = 7 * MiB;
constexpr size_t WS_WPG = 9 * MiB;
constexpr size_t WS_WPP = 11 * MiB;
constexpr size_t WS_WA = 11 * MiB + 512 * 1024;
constexpr size_t WS_WR = 11 * MiB + 768 * 1024;
constexpr size_t WS_W1 = 12 * MiB;
constexpr size_t WS_W2 = 44 * MiB;
constexpr size_t WS_SMALL = 60 * MiB;
constexpr size_t WS_RSTD1 = WS_SMALL;
constexpr size_t WS_ALOW = WS_SMALL + 64 * 1024;
constexpr size_t WS_TOKI = WS_ALOW + 1 * MiB;
constexpr size_t WS_LIST = WS_TOKI + 256 * 1024;
constexpr size_t WS_RB = 64 * MiB;
constexpr size_t WS_PB = 96 * MiB;
constexpr size_t WS_PROJ = 104 * MiB;
constexpr size_t WS_HID = WS_PROJ;
constexpr size_t WS_X2 = WS_PROJ + 44 * MiB;
constexpr size_t WS_Y = 200 * MiB;
constexpr size_t WS_X3 = WS_RB;
constexpr size_t WS_END = 256 * MiB;
static_assert(WS_LIST + (size_t)NCAT * T * 4 <= WS_RB, "small arrays fit");
static_assert(WS_Y + (size_t)T * D * 2 <= WS_END && WS_X2 + (size_t)T * D * 2 <= WS_Y, "map");

constexpr int LDS_BYTES = 147456;
constexpr int LDSCTL_OFF = 131072;

struct TokInfo { int cat; float w_lo, w_hi, rstd; };

__device__ __forceinline__ float bf2f(bf16_t v) { return __uint_as_float(((unsigned)v) << 16); }
__device__ __forceinline__ bf16_t f2bf(float f) { unsigned u = __float_as_uint(f); return (bf16_t)((u + 0x7fffu + ((u >> 16) & 1u)) >> 16); }
__device__ __forceinline__ unsigned pk2(float lo, float hi) { return (unsigned)f2bf(lo) | ((unsigned)f2bf(hi) << 16); }
__device__ __forceinline__ float wave_sum(float v) {
#pragma unroll
    for (int o = 1; o < 64; o <<= 1) v += __shfl_xor(v, o);
    return v;
}
__device__ __forceinline__ float sigmoidf_(float x) { return 1.0f / (1.0f + __expf(-x)); }
__device__ __forceinline__ float siluf_(float x) { return x * sigmoidf_(x); }
__device__ __forceinline__ float logsigmoidf_(float x) { return fminf(x, 0.f) - log1pf(__expf(-fabsf(x))); }

struct Ptrs {
    const float *x, *p, *g_mix, *w_in, *w_gla_gate, *b_gla_gate, *g_gla_out, *w_conv, *w_out, *g_moe, *w_group, *b_group, *w_router, *b_router,
        *w_exp_gate, *w_exp_up, *w_exp_down, *g_ple, *w_ple_gate, *w_ple_proj, *g_final;
    float* out; unsigned char* ws;
};

#define XB_TMO      128
#define XB_XCNT(j)  (256  + 64 * (j))
#define XB_XSUB(j)  (1280 + 64 * (j))
#define XB_XGEN(j)  (2304 + 64 * (j))
#define XB_TOP      3328
#define XB_TOPGEN   3392
#define XCD_BAR_WORDS 3456
#define XB_SPIN_CAP (1u << 18)
__device__ __forceinline__ unsigned xb_ld(unsigned* p)              { return __hip_atomic_load(p, __ATOMIC_RELAXED, __HIP_MEMORY_SCOPE_AGENT); }
__device__ __forceinline__ unsigned xb_add(unsigned* p, unsigned v) { return __hip_atomic_fetch_add(p, v, __ATOMIC_RELAXED, __HIP_MEMORY_SCOPE_AGENT); }
__device__ __forceinline__ unsigned xb_xcc_id() { return (unsigned)__builtin_amdgcn_s_getreg((3 << 11) | 20) & 0xFu; }
#define XB_SPIN(cond, bar) do { unsigned _sp = 0; while (cond) { __builtin_amdgcn_s_sleep(1); \
    if ((++_sp & 255u) == 0u) { if (xb_ld(&(bar)[XB_TMO])) break; if (_sp > XB_SPIN_CAP) { atomicAdd(&(bar)[XB_TMO], 1u); break; } } } } while (0)
struct XcdBarrier { unsigned* bar; unsigned x; volatile LAS unsigned* st; };
__device__ __forceinline__ XcdBarrier xcd_barrier_post(unsigned* bar, volatile LAS unsigned* st) {
    XcdBarrier b; b.bar = bar; b.x = xb_xcc_id(); b.st = st;
    if (threadIdx.x == 0) (void)xb_add(&bar[XB_XCNT(b.x)], 1u);
    return b;
}
__device__ __forceinline__ void xcd_barrier_complete(unsigned* bar, unsigned x, unsigned& nloc, unsigned& nx) {
    const unsigned G = gridDim.x * gridDim.y * gridDim.z;
    unsigned sum, cnt, mine, sp = 0u;
    for (;;) {
        sum = 0u; cnt = 0u; mine = 0u;
#pragma unroll
        for (unsigned j = 0; j < 16; ++j) { const unsigned c = xb_ld(&bar[XB_XCNT(j)]); sum += c; cnt += (c > 0u) ? 1u : 0u; mine = (j == x) ? c : mine; }
        if (sum == G) break;
        __builtin_amdgcn_s_sleep(1);
        if ((++sp & 255u) == 0u) { if (xb_ld(&bar[XB_TMO])) break; if (sp > XB_SPIN_CAP) { atomicAdd(&bar[XB_TMO], 1u); break; } }
    }
    nloc = mine > 0u ? mine : 1u; nx = cnt > 0u ? cnt : 1u;
}
__device__ __forceinline__ void xcd_barrier(const XcdBarrier& b) {
    asm volatile("s_waitcnt vmcnt(0)" ::: "memory");
    __syncthreads();
    if (threadIdx.x == 0) {
        unsigned* bar = b.bar;
        __builtin_amdgcn_s_waitcnt(0);
        unsigned nloc = b.st[0], nx = b.st[1];
        if (nloc == 0u) { xcd_barrier_complete(bar, b.x, nloc, nx); b.st[0] = nloc; b.st[1] = nx; }
        const unsigned old = xb_add(&bar[XB_XSUB(b.x)], 1u);
        const unsigned gen = old / nloc;
        if (old + 1u == (gen + 1u) * nloc) {
            __builtin_amdgcn_fence(__ATOMIC_RELEASE, "agent");
            asm volatile("s_waitcnt vmcnt(0)" ::: "memory");
            const unsigned og = xb_add(&bar[XB_TOP], 1u);
            const unsigned tg = og / nx;
            if (og + 1u == (tg + 1u) * nx) xb_add(&bar[XB_TOPGEN], 1u);
            else XB_SPIN(xb_ld(&bar[XB_TOPGEN]) == tg, bar);
            __builtin_amdgcn_fence(__ATOMIC_ACQUIRE, "agent");
            xb_add(&bar[XB_XGEN(b.x)], 1u);
            asm volatile("s_waitcnt vmcnt(0)" ::: "memory");
        } else {
            XB_SPIN(xb_ld(&bar[XB_XGEN(b.x)]) == gen, bar);
            __builtin_amdgcn_fence(__ATOMIC_ACQUIRE, "agent");
            asm volatile("s_waitcnt vmcnt(0)" ::: "memory");
        }
    }
    __syncthreads();
}

struct WJob { const float* src; int src_ld; const float* gain; bf16_t* dst; int dst_ld; int K, N; int mode; };
constexpr int NJOBS = 5 + 32 + 16;
__device__ __forceinline__ WJob get_job(const Ptrs& P, int j) {
    WJob w;
    if (j == 0) { w = WJob{P.w_in, DIN, P.g_mix, (bf16_t*)(P.ws + WS_WIN), D, D, NPROJ, 1}; }
    else if (j == 1) { w = WJob{P.w_in + 1536, DIN, P.g_mix, (bf16_t*)(P.ws + WS_WA), D, D, LR, 0}; }
    else if (j == 2) { w = WJob{P.w_out, D, nullptr, (bf16_t*)(P.ws + WS_WOUT), D, D, D, 0}; }
    else if (j == 3) { w = WJob{P.w_ple_gate, D, P.g_ple, (bf16_t*)(P.ws + WS_WPG), D, D, D, 0}; }
    else if (j == 4) { w = WJob{P.w_ple_proj, D, nullptr, (bf16_t*)(P.ws + WS_WPP), DPLE, DPLE, D, 0}; }
    else if (j < 37) { const int jj = j - 5, e = jj >> 1, half = jj & 1;
        w = WJob{(half ? P.w_exp_up : P.w_exp_gate) + (size_t)e * D * DE, DE, P.g_moe, (bf16_t*)(P.ws + WS_W1) + (size_t)e * D * D, D, D, DE, 2 + half}; }
    else { const int e = j - 37, g = e >> 2, el = e & 3;
        w = WJob{P.w_exp_down + (size_t)e * DE * D, D, nullptr, (bf16_t*)(P.ws + WS_W2) + (size_t)g * D * 2048 + el * DE, 2048, DE, D, 0}; }
    return w;
}
__device__ __forceinline__ int job_tiles(const WJob& w) { return ((w.N + 31) / 32) * (w.K / 32); }
__device__ __forceinline__ void transpose_tile(const WJob& w, int tile, bool valid, LAS float* tl, int gt) {
    const int nkt = w.K / 32, nt = tile / nkt, kt = tile % nkt, n0 = nt * 32, k0 = kt * 32;
    const int tx = gt & 31, ty = gt >> 5;
#pragma unroll
    for (int i = 0; i < 4; ++i) { const int kk = ty + 8 * i, n = n0 + tx; float v = 0.f;
        if (valid && n < w.N) { const int col = (w.mode == 1) ? (n < 1536 ? n : n + 16) : n; v = w.src[(size_t)(k0 + kk) * w.src_ld + col]; if (w.gain) v *= w.gain[k0 + kk]; }
        tl[kk * 33 + tx] = v; }
    __syncthreads();
#pragma unroll
    for (int i = 0; i < 4; ++i) { const int nn = ty + 8 * i, n = n0 + nn;
        if (valid && n < w.N) { const int row = (w.mode >= 2) ? (((n >> 7) << 8) + (w.mode - 2) * 128 + (n & 127)) : n;
            w.dst[(size_t)row * w.dst_ld + k0 + tx] = f2bf(tl[tx * 33 + nn]); } }
    __syncthreads();
}
__device__ __forceinline__ void phase_prep(const Ptrs& P, LAS unsigned char* lds, int tid) {
    const int grp = tid >> 8, gt = tid & 255; LAS float* tl = (LAS float*)lds + grp * (32 * 33);
    const int G2 = gridDim.x * 2, me = blockIdx.x * 2 + grp;
    int base = 0;
    for (int j = 0; j < NJOBS; ++j) { const WJob w = get_job(P, j); const int nt = job_tiles(w);
        const int first = ((me - base % G2) + G2) % G2; const int rounds = (nt + G2 - 1) / G2 + 1;
        for (int r = 0; r < rounds; ++r) { const int t = first + r * G2; transpose_tile(w, t < nt ? t : 0, t < nt, tl, gt); }
        base += nt; }
    float* WR = (float*)(P.ws + WS_WR);
    for (int i = blockIdx.x * NTHREADS + tid; i < 20 * D; i += gridDim.x * NTHREADS) { const int j = i / D, k = i % D;
        WR[i] = P.g_moe[k] * (j < 4 ? P.w_group[k * 4 + j] : P.w_router[k * NE + (j - 4)]); }
    const int lane = tid & 63, gw = blockIdx.x * 8 + (tid >> 6), ngw = gridDim.x * 8;
    bf16_t* xb = (bf16_t*)(P.ws + WS_RB); float* rstd1 = (float*)(P.ws + WS_RSTD1); bf16_t* pb = (bf16_t*)(P.ws + WS_PB);
    for (int m = gw; m < T; m += ngw) {
        const f32x4* xr = (const f32x4*)(P.x + (size_t)m * D) + lane; f32x4 v[4]; float s = 0.f;
#pragma unroll
        for (int j = 0; j < 4; ++j) { v[j] = xr[64 * j]; s += (v[j].x * v[j].x + v[j].y * v[j].y) + (v[j].z * v[j].z + v[j].w * v[j].w); }
        s = wave_sum(s);
        if (lane == 0) rstd1[m] = rsqrtf(s * (1.f / D) + EPS);
        u32x2* o = (u32x2*)(xb + (size_t)m * D) + lane;
#pragma unroll
        for (int j = 0; j < 4; ++j) { u32x2 w; w.x = pk2(v[j].x, v[j].y); w.y = pk2(v[j].z, v[j].w); o[64 * j] = w; }
        const f32x4 pv = ((const f32x4*)(P.p + (size_t)m * DPLE))[lane]; u32x2 w; w.x = pk2(pv.x, pv.y); w.y = pk2(pv.z, pv.w);
        ((u32x2*)(pb + (size_t)m * DPLE))[lane] = w;
    }
}

template <class AF, class BF, class Epi, bool DUAL>
__device__ __forceinline__ void sgemm_tile(bool valid, int m0, int n0, int K, const AF& af, const BF& bf, const Epi& epi, LAS bf16_t* sA, LAS bf16_t* sB, LAS bf16_t* sB2, int gt) {
    const int lane = gt & 63, wid = gt >> 6, wr = wid >> 1, wc = wid & 1, fr = lane & 15, fq = lane >> 4;
    f32x4 acc[2][2], acc2[2][2];
#pragma unroll
    for (int i = 0; i < 2; ++i)
#pragma unroll
        for (int j = 0; j < 2; ++j) { acc[i][j] = (f32x4){0.f, 0.f, 0.f, 0.f}; acc2[i][j] = (f32x4){0.f, 0.f, 0.f, 0.f}; }
    const int lr = gt >> 2, lc = (gt & 3) * 8;
    const bf16_t* ap = valid ? af(m0 + lr) : nullptr;
    for (int k0 = 0; k0 < K; k0 += 32) {
        u32x4 va = (u32x4){0u, 0u, 0u, 0u}, vb = va, vb2 = va;
        if (ap) va = *(const u32x4*)(ap + k0 + lc);
        if (valid) { vb = *(const u32x4*)(bf(n0 + lr, 0, k0) + lc); if (DUAL) vb2 = *(const u32x4*)(bf(n0 + lr, 1, k0) + lc); }
        *(LAS u32x4*)(sA + lr * 40 + lc) = va; *(LAS u32x4*)(sB + lr * 40 + lc) = vb;
        if (DUAL) *(LAS u32x4*)(sB2 + lr * 40 + lc) = vb2;
        __syncthreads();
        bf16x8 a[2], b[2], b2[2];
#pragma unroll
        for (int i = 0; i < 2; ++i) a[i] = *(const LAS bf16x8*)(sA + (wr * 32 + i * 16 + fr) * 40 + fq * 8);
#pragma unroll
        for (int j = 0; j < 2; ++j) { b[j] = *(const LAS bf16x8*)(sB + (wc * 32 + j * 16 + fr) * 40 + fq * 8); if (DUAL) b2[j] = *(const LAS bf16x8*)(sB2 + (wc * 32 + j * 16 + fr) * 40 + fq * 8); }
#pragma unroll
        for (int i = 0; i < 2; ++i)
#pragma unroll
            for (int j = 0; j < 2; ++j) { acc[i][j] = __builtin_amdgcn_mfma_f32_16x16x32_bf16(a[i], b[j], acc[i][j], 0, 0, 0);
                if (DUAL) acc2[i][j] = __builtin_amdgcn_mfma_f32_16x16x32_bf16(a[i], b2[j], acc2[i][j], 0, 0, 0); }
        __syncthreads();
    }
    if (!valid) return;
#pragma unroll
    for (int i = 0; i < 2; ++i)
#pragma unroll
        for (int j = 0; j < 2; ++j)
#pragma unroll
            for (int r = 0; r < 4; ++r) epi(m0 + wr * 32 + i * 16 + 4 * fq + r, n0 + wc * 32 + j * 16 + fr, acc[i][j][r], acc2[i][j][r]);
}
struct SgLds { LAS bf16_t *sA, *sB, *sB2; int gt, me, G2; };
__device__ __forceinline__ SgLds sg_setup(LAS unsigned char* lds, int tid) {
    const int grp = tid >> 8; LAS bf16_t* base = (LAS bf16_t*)lds + grp * (3 * 64 * 40);
    SgLds s; s.sA = base; s.sB = base + 64 * 40; s.sB2 = base + 2 * 64 * 40; s.gt = tid & 255; s.me = blockIdx.x * 2 + grp; s.G2 = gridDim.x * 2; return s;
}
struct AFPlain { const bf16_t* A; int lda; __device__ const bf16_t* operator()(int m) const { return A + (size_t)m * lda; } };
struct BFPlain { const bf16_t* Bt; int ldb; __device__ const bf16_t* operator()(int n, int, int k0) const { return Bt + (size_t)n * ldb + k0; } };
template <class Epi>
__device__ __forceinline__ void phase_dense(LAS unsigned char* lds, int tid, const bf16_t* A, int lda, const bf16_t* Bt, int ldb, int M, int N, int K, const Epi& ep) {
    const SgLds s = sg_setup(lds, tid); const int nn = N / 64, ntile = (M / 64) * nn, rounds = (ntile + s.G2 - 1) / s.G2;
    AFPlain af{A, lda}; BFPlain bf{Bt, ldb};
    for (int r = 0; r < rounds; ++r) { const int t = s.me + r * s.G2; const bool v = t < ntile; const int tt = v ? t : 0;
        sgemm_tile<AFPlain, BFPlain, Epi, false>(v, (tt / nn) * 64, (tt % nn) * 64, K, af, bf, ep, s.sA, s.sB, s.sB2, s.gt); }
}

struct EpiProj { bf16_t* proj; const float* rstd; __device__ void operator()(int m, int n, float v, float) const { float s = rstd[m]; if (n < 256) s *= 0.125f; proj[(size_t)m * NPROJ + n] = f2bf(v * s); } };
__device__ __forceinline__ void phase_alow(const Ptrs& P, int tid) {
    const int lane = tid & 63, gw = blockIdx.x * 8 + (tid >> 6), ngw = gridDim.x * 8;
    const bf16_t* xb = (const bf16_t*)(P.ws + WS_RB); const bf16_t* wa = (const bf16_t*)(P.ws + WS_WA); const float* rstd1 = (const float*)(P.ws + WS_RSTD1); float* alow = (float*)(P.ws + WS_ALOW);
    for (int m = gw; m < T; m += ngw) {
        float acc[LR];
#pragma unroll
        for (int j = 0; j < LR; ++j) acc[j] = 0.f;
        for (int k = lane; k < D; k += 64) { const float xv = bf2f(xb[(size_t)m * D + k]);
#pragma unroll
            for (int j = 0; j < LR; ++j) acc[j] += xv * bf2f(wa[j * D + k]); }
#pragma unroll
        for (int j = 0; j < LR; ++j) { const float s = wave_sum(acc[j]); if (lane == j) alow[(size_t)m * LR + j] = s * rstd1[m]; }
    }
}

__device__ __forceinline__ void phase_gla_naive(const Ptrs& P, int tid) {
    const int lane = tid & 63, gw = blockIdx.x * 8 + (tid >> 6);
    if (gw >= NB * H * DV) return;
    const int bh = gw >> 7, e = gw & 127, b = bh >> 2, h = bh & 3;
    const bf16_t* proj = (const bf16_t*)(P.ws + WS_PROJ); const float* alow = (const float*)(P.ws + WS_ALOW); float* obuf = (float*)(P.ws + WS_RB);
    float wg[LR];
#pragma unroll
    for (int r = 0; r < LR; ++r) wg[r] = P.w_gla_gate[r * QK + h * DK + lane];
    const float bg = P.b_gla_gate[h * DK + lane];
    float st = 0.f;
    for (int t = 0; t < S; ++t) {
        const size_t m = (size_t)b * S + t;
        float z = bg;
#pragma unroll
        for (int r = 0; r < LR; ++r) z += alow[m * LR + r] * wg[r];
        const float a = __expf(logsigmoidf_(z) * (1.f / 16.f));
        const float kv = bf2f(proj[m * NPROJ + PK + h * DK + lane]), qv = bf2f(proj[m * NPROJ + PQ + h * DK + lane]), vv = bf2f(proj[m * NPROJ + PV + h * DV + e]);
        st = a * st + kv * vv;
        const float o = wave_sum(qv * st);
        if (lane == 0) obuf[m * GV + h * DV + e] = o;
    }
}
__device__ __forceinline__ void phase_mix_post(const Ptrs& P, int tid) {
    const int lane = tid & 63, gw = blockIdx.x * 8 + (tid >> 6), ngw = gridDim.x * 8;
    const bf16_t* proj = (const bf16_t*)(P.ws + WS_PROJ); const float* obuf = (const float*)(P.ws + WS_RB); bf16_t* y = (bf16_t*)(P.ws + WS_Y);
    for (int m = gw; m < T; m += ngw) {
#pragma unroll
        for (int h = 0; h < H; ++h) {
            const float o0 = obuf[(size_t)m * GV + h * DV + lane], o1 = obuf[(size_t)m * GV + h * DV + 64 + lane];
            const float ss = wave_sum(o0 * o0 + o1 * o1), r = rsqrtf(ss * (1.f / DV) + EPS);
            const float g0 = bf2f(proj[(size_t)m * NPROJ + PG + h * DV + lane]), g1 = bf2f(proj[(size_t)m * NPROJ + PG + h * DV + 64 + lane]);
            y[(size_t)m * D + h * DV + lane] = f2bf(o0 * r * P.g_gla_out[lane] * siluf_(g0));
            y[(size_t)m * D + h * DV + 64 + lane] = f2bf(o1 * r * P.g_gla_out[64 + lane] * siluf_(g1));
        }
        const int t = m % S;
        for (int c = lane; c < CW; c += 64) {
            float acc = 0.f;
#pragma unroll
            for (int j = 0; j < 3; ++j) { const int tt = t - 2 + j; if (tt >= 0) { const size_t mm = (size_t)m - 2 + j;
                acc += P.w_conv[j * CW + c] * (bf2f(proj[mm * NPROJ + PC + c]) * bf2f(proj[mm * NPROJ + PU + c])); } }
            y[(size_t)m * D + GV + c] = f2bf(bf2f(proj[(size_t)m * NPROJ + PB + c]) * acc);
        }
    }
}
struct EpiOut { const float* x; bf16_t* x1; float* ssq; __device__ void operator()(int m, int n, float v, float) const { const float r = x[(size_t)m * D + n] + v; x1[(size_t)m * D + n] = f2bf(r); atomicAdd(ssq + m, r * r); } };
__device__ __forceinline__ void phase_route(const Ptrs& P, int tid) {
    const int lane = tid & 63, gw = blockIdx.x * 8 + (tid >> 6), ngw = gridDim.x * 8;
    const bf16_t* x1 = (const bf16_t*)(P.ws + WS_RB); const float* WR = (const float*)(P.ws + WS_WR); const float* ssq2 = (const float*)(P.ws + WS_SSQ2);
    TokInfo* ti = (TokInfo*)(P.ws + WS_TOKI); int* lists = (int*)(P.ws + WS_LIST); unsigned* cnt = (unsigned*)(P.ws + WS_CTL);
    for (int m = gw; m < T; m += ngw) {
        float acc[20];
#pragma unroll
        for (int j = 0; j < 20; ++j) acc[j] = 0.f;
        for (int k = lane; k < D; k += 64) { const float xv = bf2f(x1[(size_t)m * D + k]);
#pragma unroll
            for (int j = 0; j < 20; ++j) acc[j] += xv * WR[j * D + k]; }
#pragma unroll
        for (int j = 0; j < 20; ++j) acc[j] = wave_sum(acc[j]);
        if (lane == 0) {
            const float rstd = rsqrtf(ssq2[m] * (1.f / D) + EPS);
            float gl[4]; int gs = 0;
#pragma unroll
            for (int j = 0; j < 4; ++j) gl[j] = acc[j] * rstd + P.b_group[j];
            float gbest = gl[0];
#pragma unroll
            for (int j = 1; j < 4; ++j) if (gl[j] > gbest) { gbest = gl[j]; gs = j; }
            float den = 0.f;
#pragma unroll
            for (int j = 0; j < 4; ++j) den += __expf(gl[j] - gbest);
            const float pgrp = 1.f / den;
            float el[4];
#pragma unroll
            for (int j = 0; j < 4; ++j) { float v = 0.f;
#pragma unroll
                for (int g = 0; g < 4; ++g) if (g == gs) v = acc[4 + g * 4 + j] * rstd + P.b_router[g * 4 + j];
                el[j] = v; }
            int i0 = 0; float v0 = el[0];
#pragma unroll
            for (int j = 1; j < 4; ++j) if (el[j] > v0) { v0 = el[j]; i0 = j; }
            int i1 = -1; float v1 = -3.0e38f;
#pragma unroll
            for (int j = 0; j < 4; ++j) if (j != i0 && el[j] > v1) { v1 = el[j]; i1 = j; }
            const float e1 = __expf(v1 - v0);
            const float w0 = pgrp / (1.f + e1), w1 = pgrp * e1 / (1.f + e1);
            const int lo = i0 < i1 ? i0 : i1, hi = i0 < i1 ? i1 : i0;
            const int pidx = (lo == 0) ? (hi - 1) : (lo == 1 ? (hi + 1) : 5);
            const int cat = gs * 6 + pidx;
            TokInfo info; info.cat = cat; info.w_lo = (i0 < i1) ? w0 : w1; info.w_hi = (i0 < i1) ? w1 : w0; info.rstd = rstd;
            ti[m] = info;
            const unsigned slot = atomicAdd(cnt + cat, 1u);
            lists[(size_t)cat * T + slot] = m;
        }
    }
}
__device__ __forceinline__ void cat_experts(int cat, int& e_lo, int& e_hi) {
    const int g = cat / 6, p = cat % 6; int lo, hi;
    if (p < 3) { lo = 0; hi = p + 1; } else if (p < 5) { lo = 1; hi = p - 1; } else { lo = 2; hi = 3; }
    e_lo = g * 4 + lo; e_hi = g * 4 + hi;
}
__device__ __forceinline__ bool rowtile_lookup(const unsigned* cnt, int rt, int& cat, int& slot0, int& n) {
    int base = 0;
    for (int c = 0; c < NCAT; ++c) { const int nc = (int)__hip_atomic_load(cnt + c, __ATOMIC_RELAXED, __HIP_MEMORY_SCOPE_AGENT), ntile = (nc + 255) >> 8; if (rt < base + ntile) { cat = c; slot0 = (rt - base) * 256; n = nc; return true; } base += ntile; }
    cat = 0; slot0 = 0; n = 0; return false;
}
struct AFGather { const bf16_t* X; const int* list; int slot0, n; __device__ const bf16_t* operator()(int m) const { const int s = slot0 + (m & 255); return s < n ? X + (size_t)list[s] * D : nullptr; } };
struct BFW1 { const bf16_t* W1; int e_lo, e_hi; __device__ const bf16_t* operator()(int n, int which, int k0) const {
    const int kx = n >> 9, j = n & 511, row = ((j >> 7) << 8) + which * 128 + (j & 127); return W1 + (size_t)(kx ? e_hi : e_lo) * D * D + (size_t)row * D + k0; } };
struct EpiHid { bf16_t* hid; const TokInfo* ti; const int* list; int slot0, n; __device__ void operator()(int m, int nn, float vg, float vu) const {
    const int s = slot0 + (m & 255); float o = 0.f;
    if (s < n) { const TokInfo t = ti[list[s]]; const float w = (nn >> 9) ? t.w_hi : t.w_lo; o = siluf_(vg * t.rstd) * (vu * t.rstd) * w; }
    hid[(size_t)m * D + nn] = f2bf(o); } };
__device__ __forceinline__ void phase_moe1(const Ptrs& P, LAS unsigned char* lds, int tid) {
    const SgLds s = sg_setup(lds, tid); const unsigned* cnt = (const unsigned*)(P.ws + WS_CTL);
    const int ntile = MAXRT * 4 * 16, rounds = (ntile + s.G2 - 1) / s.G2;
    for (int r = 0; r < rounds; ++r) { const int t = s.me + r * s.G2; const int tm = t >> 4, tn = t & 15, m0 = tm * 64; int cat, slot0, n;
        const bool v = (t < ntile) && rowtile_lookup(cnt, m0 >> 8, cat, slot0, n);
        int e_lo, e_hi; cat_experts(cat, e_lo, e_hi);
        const int* list = (const int*)(P.ws + WS_LIST) + (size_t)cat * T;
        AFGather af{(const bf16_t*)(P.ws + WS_RB), list, slot0, n}; BFW1 bf{(const bf16_t*)(P.ws + WS_W1), e_lo, e_hi};
        EpiHid ep{(bf16_t*)(P.ws + WS_HID), (const TokInfo*)(P.ws + WS_TOKI), list, slot0, n};
        sgemm_tile<AFGather, BFW1, EpiHid, true>(v, m0, tn * 64, D, af, bf, ep, s.sA, s.sB, s.sB2, s.gt); }
}
struct BFW2 { const bf16_t* W2g; int el_lo, el_hi; __device__ const bf16_t* operator()(int n, int, int k0) const {
    return W2g + (size_t)n * 2048 + (k0 < 512 ? el_lo * 512 + k0 : el_hi * 512 + (k0 - 512)); } };
struct EpiX2 { const bf16_t* x1; bf16_t* x2; float* ssq; const int* list; int slot0, n; __device__ void operator()(int m, int nn, float v, float) const {
    const int s = slot0 + (m & 255); if (s < n) { const int tok = list[s]; const float r = bf2f(x1[(size_t)tok * D + nn]) + v; x2[(size_t)tok * D + nn] = f2bf(r); atomicAdd(ssq + tok, r * r); } } };
__device__ __forceinline__ void phase_moe2(const Ptrs& P, LAS unsigned char* lds, int tid) {
    const SgLds s = sg_setup(lds, tid); const unsigned* cnt = (const unsigned*)(P.ws + WS_CTL);
    const int ntile = MAXRT * 4 * 16, rounds = (ntile + s.G2 - 1) / s.G2;
    for (int r = 0; r < rounds; ++r) { const int t = s.me + r * s.G2; const int tm = t >> 4, tn = t & 15, m0 = tm * 64; int cat, slot0, n;
        const bool v = (t < ntile) && rowtile_lookup(cnt, m0 >> 8, cat, slot0, n);
        int e_lo, e_hi; cat_experts(cat, e_lo, e_hi);
        const int* list = (const int*)(P.ws + WS_LIST) + (size_t)cat * T;
        AFPlain af{(const bf16_t*)(P.ws + WS_HID), D}; BFW2 bf{(const bf16_t*)(P.ws + WS_W2) + (size_t)(cat / 6) * D * 2048, e_lo & 3, e_hi & 3};
        EpiX2 ep{(const bf16_t*)(P.ws + WS_RB), (bf16_t*)(P.ws + WS_X2), (float*)(P.ws + WS_SSQ3), list, slot0, n};
        sgemm_tile<AFPlain, BFW2, EpiX2, false>(v, m0, tn * 64, D, af, bf, ep, s.sA, s.sB, s.sB2, s.gt); }
}
struct EpiPP { bf16_t* pp; __device__ void operator()(int m, int n, float v, float) const { pp[(size_t)m * D + n] = f2bf(v); } };
struct EpiPle { const bf16_t* x2; const bf16_t* pp; const float* ssq3; bf16_t* x3; float* ssq4; __device__ void operator()(int m, int n, float v, float) const {
    const float rstd = rsqrtf(ssq3[m] * (1.f / D) + EPS); const float r = bf2f(x2[(size_t)m * D + n]) + sigmoidf_(v * rstd) * bf2f(pp[(size_t)m * D + n]);
    x3[(size_t)m * D + n] = f2bf(r); atomicAdd(ssq4 + m, r * r); } };
__device__ __forceinline__ void phase_final(const Ptrs& P, int tid) {
    const int lane = tid & 63, gw = blockIdx.x * 8 + (tid >> 6), ngw = gridDim.x * 8;
    const bf16_t* x3 = (const bf16_t*)(P.ws + WS_X3); const float* ssq4 = (const float*)(P.ws + WS_SSQ4);
    for (int m = gw; m < T; m += ngw) {
        const float rstd = rsqrtf(ssq4[m] * (1.f / D) + EPS);
        for (int c = lane; c < D; c += 64) P.out[(size_t)m * D + c] = bf2f(x3[(size_t)m * D + c]) * rstd * P.g_final[c];
    }
}

__global__ void __launch_bounds__(NTHREADS, 2) mega_fwd(Ptrs P) {
    extern __shared__ __attribute__((aligned(16))) unsigned char lds_raw[];
    LAS unsigned char* lds = (LAS unsigned char*)lds_raw;
    const int tid = threadIdx.x;
    LAS unsigned* lctl = (LAS unsigned*)(lds + LDSCTL_OFF);
    for (int u = tid; u < 64; u += NTHREADS) lctl[u] = 0u;
    __syncthreads();
    XcdBarrier bar = xcd_barrier_post((unsigned*)(P.ws + WS_CTL) + CW_BAR, (volatile LAS unsigned*)(lctl + 8));

    phase_prep(P, lds, tid);
    xcd_barrier(bar);
    { EpiProj ep{(bf16_t*)(P.ws + WS_PROJ), (const float*)(P.ws + WS_RSTD1)};
      phase_dense<EpiProj>(lds, tid, (const bf16_t*)(P.ws + WS_RB), D, (const bf16_t*)(P.ws + WS_WIN), D, T, NPROJ, D, ep); }
    phase_alow(P, tid);
    xcd_barrier(bar);
    phase_gla_naive(P, tid);
    xcd_barrier(bar);
    phase_mix_post(P, tid);
    xcd_barrier(bar);
    { EpiOut ep{P.x, (bf16_t*)(P.ws + WS_RB), (float*)(P.ws + WS_SSQ2)};
      phase_dense<EpiOut>(lds, tid, (const bf16_t*)(P.ws + WS_Y), D, (const bf16_t*)(P.ws + WS_WOUT), D, T, D, D, ep); }
    xcd_barrier(bar);
    phase_route(P, tid);
    xcd_barrier(bar);
    phase_moe1(P, lds, tid);
    { EpiPP ep{(bf16_t*)(P.ws + WS_Y)};
      phase_dense<EpiPP>(lds, tid, (const bf16_t*)(P.ws + WS_PB), DPLE, (const bf16_t*)(P.ws + WS_WPP), DPLE, T, D, DPLE, ep); }
    xcd_barrier(bar);
    phase_moe2(P, lds, tid);
    xcd_barrier(bar);
    { EpiPle ep{(const bf16_t*)(P.ws + WS_X2), (const bf16_t*)(P.ws + WS_Y), (const float*)(P.ws + WS_SSQ3), (bf16_t*)(P.ws + WS_X3), (float*)(P.ws + WS_SSQ4)};
      phase_dense<EpiPle>(lds, tid, (const bf16_t*)(P.ws + WS_X2), D, (const bf16_t*)(P.ws + WS_WPG), D, T, D, D, ep); }
    xcd_barrier(bar);
    phase_final(P, tid);
}

extern "C" void kernel_launch(void* const* d_in, const int* in_sizes, int n_in, void* d_out, int out_size, void* d_ws, size_t ws_size, hipStream_t stream) {
    static int grid = 0;
    if (grid == 0) {
        if (n_in != 21 || in_sizes[0] != T * D || out_size != T * D || ws_size < WS_END) {
            fprintf(stderr, "kernel_launch: unexpected shapes: n_in %d in0 %d out %d ws %zu\n", n_in, n_in > 0 ? in_sizes[0] : -1, out_size, ws_size); grid = -1; return; }
        int dev = 0, cus = 0, per_cu = 0;
        if (hipGetDevice(&dev) != hipSuccess || hipDeviceGetAttribute(&cus, hipDeviceAttributeMultiprocessorCount, dev) != hipSuccess) { grid = -1; return; }
        if (hipFuncSetAttribute((const void*)mega_fwd, hipFuncAttributeMaxDynamicSharedMemorySize, LDS_BYTES) != hipSuccess) { fprintf(stderr, "kernel_launch: hipFuncSetAttribute failed\n"); grid = -1; return; }
        if (hipOccupancyMaxActiveBlocksPerMultiprocessor(&per_cu, (const void*)mega_fwd, NTHREADS, LDS_BYTES) != hipSuccess || per_cu < 1) {
            fprintf(stderr, "kernel_launch: occupancy query says %d workgroups per CU; not launching\n", per_cu); grid = -1; return; }
        (void)hipGetLastError();
        grid = cus;
    }
    if (grid < 0) return;
    Ptrs P{};
    const float** pp = (const float**)&P;
    for (int i = 0; i < 21; ++i) pp[i] = (const float*)d_in[i];
    P.out = (float*)d_out; P.ws = (unsigned char*)d_ws;
    if (hipMemsetAsync((char*)d_ws + WS_CTL, 0, CTL_BYTES, stream) != hipSuccess) { fprintf(stderr, "kernel_launch: memset failed\n"); return; }
    hipLaunchKernelGGL(mega_fwd, dim3(grid), dim3(NTHREADS), LDS_BYTES, stream, P);
}
```

```cpp
#include <hip/hip_runtime.h>
#include <cstdio>
#include <cstdint>

typedef unsigned short bf16_t;
typedef short bf16x8 __attribute__((ext_vector_type(8)));
typedef float f32x4 __attribute__((ext_vector_type(4)));
typedef unsigned u32x4 __attribute__((ext_vector_type(4)));
typedef unsigned u32x2 __attribute__((ext_vector_type(2)));
#define LAS __attribute__((address_space(3)))

constexpr int D = 1024, NB = 2, S = 8192, T = NB * S, DPLE = 256;
constexpr int H = 4, DK = 64, DV = 128, LR = 16, QK = 256, GV = 512, CW = 512;
constexpr int DIN = 3088, NPROJ = 3072;
constexpr int NE = 16, DE = 512, NCAT = 24;
constexpr float EPS = 1e-6f;
constexpr int PQ = 0, PK = 256, PV = 512, PG = 1024, PB = 1536, PC = 2048, PU = 2560;
constexpr int MAXRT = 88;
constexpr int NTHREADS = 512;

constexpr size_t MiB = 1u << 20;
constexpr size_t WS_CTL = 0, CTL_BYTES = 1 * MiB;
constexpr int CW_BAR = 4096;
constexpr size_t WS_SSQ2 = 256 * 1024;
constexpr size_t WS_SSQ3 = WS_SSQ2 + 64 * 1024;
constexpr size_t WS_SSQ4 = WS_SSQ3 + 64 * 1024;
constexpr size_t WS_WIN = 1 * MiB;
constexpr size_t WS_WOUT = 7 * MiB;
constexpr size_t WS_WPG = 9 * MiB;
constexpr size_t WS_WPP = 11 * MiB;
constexpr size_t WS_WA = 11 * MiB + 512 * 1024;
constexpr size_t WS_WR = 11 * MiB + 768 * 1024;
constexpr size_t WS_W1 = 12 * MiB;
constexpr size_t WS_W2 = 44 * MiB;
constexpr size_t WS_SMALL = 60 * MiB;
constexpr size_t WS_RSTD1 = WS_SMALL;
constexpr size_t WS_ALOW = WS_SMALL + 64 * 1024;
constexpr size_t WS_TOKI = WS_ALOW + 1 * MiB;
constexpr size_t WS_LIST = WS_TOKI + 256 * 1024;
constexpr size_t WS_RB = 64 * MiB;
constexpr size_t WS_PB = 96 * MiB;
constexpr size_t WS_PROJ = 104 * MiB;
constexpr size_t WS_HID = WS_PROJ;
constexpr size_t WS_X2 = WS_PROJ + 44 * MiB;
constexpr size_t WS_Y = 200 * MiB;
constexpr size_t WS_X3 = WS_RB;
constexpr size_t WS_END = 256 * MiB;
static_assert(WS_LIST + (size_t)NCAT * T * 4 <= WS_RB, "small arrays fit");
static_assert(WS_Y + (size_t)T * D * 2 <= WS_END && WS_X2 + (size_t)T * D * 2 <= WS_Y, "map");

constexpr int LDS_BYTES = 147456;
constexpr int LDSCTL_OFF = 131072;

struct TokInfo { int cat; float w_lo, w_hi, rstd; };

__device__ __forceinline__ float bf2f(bf16_t v) { return __uint_as_float(((unsigned)v) << 16); }
__device__ __forceinline__ bf16_t f2bf(float f) { unsigned u = __float_as_uint(f); return (bf16_t)((u + 0x7fffu + ((u >> 16) & 1u)) >> 16); }
__device__ __forceinline__ unsigned pk2(float lo, float hi) { return (unsigned)f2bf(lo) | ((unsigned)f2bf(hi) << 16); }
__device__ __forceinline__ float wave_sum(float v) {
#pragma unroll
    for (int o = 1; o < 64; o <<= 1) v += __shfl_xor(v, o);
    return v;
}
__device__ __forceinline__ float sigmoidf_(float x) { return 1.0f / (1.0f + __expf(-x)); }
__device__ __forceinline__ float siluf_(float x) { return x * sigmoidf_(x); }
__device__ __forceinline__ float logsigmoidf_(float x) { return fminf(x, 0.f) - log1pf(__expf(-fabsf(x))); }

struct Ptrs {
    const float *x, *p, *g_mix, *w_in, *w_gla_gate, *b_gla_gate, *g_gla_out, *w_conv, *w_out, *g_moe, *w_group, *b_group, *w_router, *b_router,
        *w_exp_gate, *w_exp_up, *w_exp_down, *g_ple, *w_ple_gate, *w_ple_proj, *g_final;
    float* out; unsigned char* ws;
};

#define XB_TMO      128
#define XB_XCNT(j)  (256  + 64 * (j))
#define XB_XSUB(j)  (1280 + 64 * (j))
#define XB_XGEN(j)  (2304 + 64 * (j))
#define XB_TOP      3328
#define XB_TOPGEN   3392
#define XCD_BAR_WORDS 3456
#define XB_SPIN_CAP (1u << 18)
__device__ __forceinline__ unsigned xb_ld(unsigned* p)              { return __hip_atomic_load(p, __ATOMIC_RELAXED, __HIP_MEMORY_SCOPE_AGENT); }
__device__ __forceinline__ unsigned xb_add(unsigned* p, unsigned v) { return __hip_atomic_fetch_add(p, v, __ATOMIC_RELAXED, __HIP_MEMORY_SCOPE_AGENT); }
__device__ __forceinline__ unsigned xb_xcc_id() { return (unsigned)__builtin_amdgcn_s_getreg((3 << 11) | 20) & 0xFu; }
#define XB_SPIN(cond, bar) do { unsigned _sp = 0; while (cond) { __builtin_amdgcn_s_sleep(1); \
    if ((++_sp & 255u) == 0u) { if (xb_ld(&(bar)[XB_TMO])) break; if (_sp > XB_SPIN_CAP) { atomicAdd(&(bar)[XB_TMO], 1u); break; } } } } while (0)
struct XcdBarrier { unsigned* bar; unsigned x; volatile LAS unsigned* st; };
__device__ __forceinline__ XcdBarrier xcd_barrier_post(unsigned* bar, volatile LAS unsigned* st) {
    XcdBarrier b; b.bar = bar; b.x = xb_xcc_id(); b.st = st;
    if (threadIdx.x == 0) (void)xb_add(&bar[XB_XCNT(b.x)], 1u);
    return b;
}
__device__ __forceinline__ void xcd_barrier_complete(unsigned* bar, unsigned x, unsigned& nloc, unsigned& nx) {
    const unsigned G = gridDim.x * gridDim.y * gridDim.z;
    unsigned sum, cnt, mine, sp = 0u;
    for (;;) {
        sum = 0u; cnt = 0u; mine = 0u;
#pragma unroll
        for (unsigned j = 0; j < 16; ++j) { const unsigned c = xb_ld(&bar[XB_XCNT(j)]); sum += c; cnt += (c > 0u) ? 1u : 0u; mine = (j == x) ? c : mine; }
        if (sum == G) break;
        __builtin_amdgcn_s_sleep(1);
        if ((++sp & 255u) == 0u) { if (xb_ld(&bar[XB_TMO])) break; if (sp > XB_SPIN_CAP) { atomicAdd(&bar[XB_TMO], 1u); break; } }
    }
    nloc = mine > 0u ? mine : 1u; nx = cnt > 0u ? cnt : 1u;
}
__device__ __forceinline__ void xcd_barrier(const XcdBarrier& b) {
    asm volatile("s_waitcnt vmcnt(0)" ::: "memory");
    __syncthreads();
    if (threadIdx.x == 0) {
        unsigned* bar = b.bar;
        __builtin_amdgcn_s_waitcnt(0);
        unsigned nloc = b.st[0], nx = b.st[1];
        if (nloc == 0u) { xcd_barrier_complete(bar, b.x, nloc, nx); b.st[0] = nloc; b.st[1] = nx; }
        const unsigned old = xb_add(&bar[XB_XSUB(b.x)], 1u);
        const unsigned gen = old / nloc;
        if (old + 1u == (gen + 1u) * nloc) {
            __builtin_amdgcn_fence(__ATOMIC_RELEASE, "agent");
            asm volatile("s_waitcnt vmcnt(0)" ::: "memory");
            const unsigned og = xb_add(&bar[XB_TOP], 1u);
            const unsigned tg = og / nx;
            if (og + 1u == (tg + 1u) * nx) xb_add(&bar[XB_TOPGEN], 1u);
            else XB_SPIN(xb_ld(&bar[XB_TOPGEN]) == tg, bar);
            __builtin_amdgcn_fence(__ATOMIC_ACQUIRE, "agent");
            xb_add(&bar[XB_XGEN(b.x)], 1u);
            asm volatile("s_waitcnt vmcnt(0)" ::: "memory");
        } else {
            XB_SPIN(xb_ld(&bar[XB_XGEN(b.x)]) == gen, bar);
            __builtin_amdgcn_fence(__ATOMIC_ACQUIRE, "agent");
            asm volatile("s_waitcnt vmcnt(0)" ::: "memory");
        }
    }
    __syncthreads();
}

struct WJob { const float* src; int src_ld; const float* gain; bf16_t* dst; int dst_ld; int K, N; int mode; };
constexpr int NJOBS = 5 + 32 + 16;
__device__ __forceinline__ WJob get_job(const Ptrs& P, int j) {
    WJob w;
    if (j == 0) { w = WJob{P.w_in, DIN, P.g_mix, (bf16_t*)(P.ws + WS_WIN), D, D, NPROJ, 1}; }
    else if (j == 1) { w = WJob{P.w_in + 1536, DIN, P.g_mix, (bf16_t*)(P.ws + WS_WA), D, D, LR, 0}; }
    else if (j == 2) { w = WJob{P.w_out, D, nullptr, (bf16_t*)(P.ws + WS_WOUT), D, D, D, 0}; }
    else if (j == 3) { w = WJob{P.w_ple_gate, D, P.g_ple, (bf16_t*)(P.ws + WS_WPG), D, D, D, 0}; }
    else if (j == 4) { w = WJob{P.w_ple_proj, D, nullptr, (bf16_t*)(P.ws + WS_WPP), DPLE, DPLE, D, 0}; }
    else if (j < 37) { const int jj = j - 5, e = jj >> 1, half = jj & 1;
        w = WJob{(half ? P.w_exp_up : P.w_exp_gate) + (size_t)e * D * DE, DE, P.g_moe, (bf16_t*)(P.ws + WS_W1) + (size_t)e * D * D, D, D, DE, 2 + half}; }
    else { const int e = j - 37, g = e >> 2, el = e & 3;
        w = WJob{P.w_exp_down + (size_t)e * DE * D, D, nullptr, (bf16_t*)(P.ws + WS_W2) + (size_t)g * D * 2048 + el * DE, 2048, DE, D, 0}; }
    return w;
}
__device__ __forceinline__ int job_tiles(const WJob& w) { return ((w.N + 31) / 32) * (w.K / 32); }
__device__ __forceinline__ void transpose_tile(const WJob& w, int tile, bool valid, LAS float* tl, int gt) {
    const int nkt = w.K / 32, nt = tile / nkt, kt = tile % nkt, n0 = nt * 32, k0 = kt * 32;
    const int tx = gt & 31, ty = gt >> 5;
#pragma unroll
    for (int i = 0; i < 4; ++i) { const int kk = ty + 8 * i, n = n0 + tx; float v = 0.f;
        if (valid && n < w.N) { const int col = (w.mode == 1) ? (n < 1536 ? n : n + 16) : n; v = w.src[(size_t)(k0 + kk) * w.src_ld + col]; if (w.gain) v *= w.gain[k0 + kk]; }
        tl[kk * 33 + tx] = v; }
    __syncthreads();
#pragma unroll
    for (int i = 0; i < 4; ++i) { const int nn = ty + 8 * i, n = n0 + nn;
        if (valid && n < w.N) { const int row = (w.mode >= 2) ? (((n >> 7) << 8) + (w.mode - 2) * 128 + (n & 127)) : n;
            w.dst[(size_t)row * w.dst_ld + k0 + tx] = f2bf(tl[tx * 33 + nn]); } }
    __syncthreads();
}
__device__ __forceinline__ void phase_prep(const Ptrs& P, LAS unsigned char* lds, int tid) {
    const int grp = tid >> 8, gt = tid & 255; LAS float* tl = (LAS float*)lds + grp * (32 * 33);
    const int G2 = gridDim.x * 2, me = blockIdx.x * 2 + grp;
    int base = 0;
    for (int j = 0; j < NJOBS; ++j) { const WJob w = get_job(P, j); const int nt = job_tiles(w);
        const int first = ((me - base % G2) + G2) % G2; const int rounds = (nt + G2 - 1) / G2 + 1;
        for (int r = 0; r < rounds; ++r) { const int t = first + r * G2; transpose_tile(w, t < nt ? t : 0, t < nt, tl, gt); }
        base += nt; }
    float* WR = (float*)(P.ws + WS_WR);
    for (int i = blockIdx.x * NTHREADS + tid; i < 20 * D; i += gridDim.x * NTHREADS) { const int j = i / D, k = i % D;
        WR[i] = P.g_moe[k] * (j < 4 ? P.w_group[k * 4 + j] : P.w_router[k * NE + (j - 4)]); }
    const int lane = tid & 63, gw = blockIdx.x * 8 + (tid >> 6), ngw = gridDim.x * 8;
    bf16_t* xb = (bf16_t*)(P.ws + WS_RB); float* rstd1 = (float*)(P.ws + WS_RSTD1); bf16_t* pb = (bf16_t*)(P.ws + WS_PB);
    for (int m = gw; m < T; m += ngw) {
        const f32x4* xr = (const f32x4*)(P.x + (size_t)m * D) + lane; f32x4 v[4]; float s = 0.f;
#pragma unroll
        for (int j = 0; j < 4; ++j) { v[j] = xr[64 * j]; s += (v[j].x * v[j].x + v[j].y * v[j].y) + (v[j].z * v[j].z + v[j].w * v[j].w); }
        s = wave_sum(s);
        if (lane == 0) rstd1[m] = rsqrtf(s * (1.f / D) + EPS);
        u32x2* o = (u32x2*)(xb + (size_t)m * D) + lane;
#pragma unroll
        for (int j = 0; j < 4; ++j) { u32x2 w; w.x = pk2(v[j].x, v[j].y); w.y = pk2(v[j].z, v[j].w); o[64 * j] = w; }
        const f32x4 pv = ((const f32x4*)(P.p + (size_t)m * DPLE))[lane]; u32x2 w; w.x = pk2(pv.x, pv.y); w.y = pk2(pv.z, pv.w);
        ((u32x2*)(pb + (size_t)m * DPLE))[lane] = w;
    }
}

namespace pg8 {
constexpr int BM = 256, BK = 64, HALF = 128, HTB = HALF * BK * 2, STAGE_BYTES = 8 * HTB, NXCD = 8, WGM = 8;
__device__ __forceinline__ int lds_byte(int r, int c) { const int st = (r >> 4) * 2 + (c >> 5), rr = r & 15, cc = c & 31, ob = rr * 64 + cc * 2; return st * 1024 + (ob ^ (((ob >> 9) & 1) << 5)); }
__device__ __forceinline__ void stage_rc(int b, int& R, int& C) { const int st = b / 1024, sb = b % 1024, swz = sb ^ (((sb >> 9) & 1) << 5); R = (st >> 1) * 16 + swz / 64; C = (st & 1) * 32 + (swz % 64) / 2; }
__device__ __forceinline__ int perm32(int rho) { const int n = rho >> 4, i = rho & 15; return 8 * (i >> 2) + 4 * n + (i & 3); }
__device__ __forceinline__ unsigned cvt_pk_bf16(float lo, float hi) { unsigned r; asm volatile("v_cvt_pk_bf16_f32 %0, %1, %2" : "=v"(r) : "v"(lo), "v"(hi)); return r; }

struct StaticOrder {
    int nM, nN, nwg, G, c;
    __device__ void init(int M, int N, int G_, int c_) { nM = M / BM; nN = N / BM; nwg = nM * nN; G = G_; c = c_; }
    __device__ bool next(int i, int& pm, int& pn) const {
        const long L = (long)i * G + c; if (L >= nwg) return false;
        int wgid = (int)L; { const int q = nwg / NXCD, r = nwg % NXCD, xcd = wgid % NXCD, off = wgid / NXCD; wgid = (xcd < r ? xcd * (q + 1) : r * (q + 1) + (xcd - r) * q) + off; }
        const int nig = WGM * nN, gid = wgid / nig, fm = gid * WGM, gsz = (nM - fm) < WGM ? (nM - fm) : WGM;
        pm = fm + ((wgid % nig) % gsz); pn = (wgid % nig) / gsz; return true;
    }
};

template <class Pb, class Epi, bool ALIGN_EPI>
__device__ __forceinline__ void gemm_phase(LAS unsigned char* lds, const Pb& S, const Epi& E) {
    const int tid = threadIdx.x, wid = __builtin_amdgcn_readfirstlane(tid >> 6), lane = tid & 63, wr = wid >> 2, wc = wid & 3, fr = lane & 15, fq = lane >> 4;
    const int nt = S.nt();
    int R[2], C[2]; unsigned voffB[2];
#pragma unroll
    for (int i = 0; i < 2; ++i) { stage_rc(tid * 16 + i * 8192, R[i], C[i]); const int Rb = Epi::PERM ? ((R[i] & ~31) + perm32(R[i] & 31)) : R[i]; voffB[i] = (unsigned)(Rb * (int)S.ldb() + C[i]) * 2u; }
    const size_t hstepB = (size_t)HALF * S.ldb() * 2;
    const unsigned ldsw = (unsigned)wid * 1024u;
    const int aoff = lds_byte(wr * 64 + fr, fq * 8), boff = lds_byte(wc * 32 + fr, fq * 8);
    const char* const abase = S.a_base();
#define PG8_SA(b, h) (((b) * 2 + (h)) * HTB)
#define PG8_SB(b, h) ((4 + (b) * 2 + (h)) * HTB)
#define PG8_STAGE_B(bufoff, gbase) do { _Pragma("unroll") for (int _i = 0; _i < 2; ++_i) \
        __builtin_amdgcn_global_load_lds((const unsigned*)((const char*)(gbase) + voffB[_i]), (LAS unsigned*)(lds + (bufoff) + ldsw + _i * 8192), 16, 0, 0); } while (0)
#define PG8_STAGE_A(bufoff, kbase, o0, o1) do { \
        __builtin_amdgcn_global_load_lds((const unsigned*)((kbase) + (o0)), (LAS unsigned*)(lds + (bufoff) + ldsw), 16, 0, 0); \
        __builtin_amdgcn_global_load_lds((const unsigned*)((kbase) + (o1)), (LAS unsigned*)(lds + (bufoff) + ldsw + 8192), 16, 0, 0); } while (0)
#define PG8_LDA(dst, b, h) do { _Pragma("unroll") for (int m = 0; m < 4; ++m) _Pragma("unroll") for (int k = 0; k < 2; ++k) dst[m][k] = *(const LAS bf16x8*)(lds + PG8_SA(b, h) + aoff + m * 2048 + k * 1024); } while (0)
#define PG8_LDB(dst, b, h) do { _Pragma("unroll") for (int n = 0; n < 2; ++n) _Pragma("unroll") for (int k = 0; k < 2; ++k) dst[n][k] = *(const LAS bf16x8*)(lds + PG8_SB(b, h) + boff + n * 2048 + k * 1024); } while (0)
#define PG8_MMA(ai, bj, At, Bt) do { __builtin_amdgcn_s_setprio(1); _Pragma("unroll") for (int m = 0; m < 4; ++m) _Pragma("unroll") for (int n = 0; n < 2; ++n) _Pragma("unroll") for (int k = 0; k < 2; ++k) \
        acc[ai][bj][m][n] = __builtin_amdgcn_mfma_f32_16x16x32_bf16(Bt[n][k], At[m][k], acc[ai][bj][m][n], 0, 0, 0); __builtin_amdgcn_s_setprio(0); } while (0)
#define PG8_WAIT_V(n) asm volatile("s_waitcnt vmcnt(" #n ")" ::: "memory")
#define PG8_WAIT_L(n) asm volatile("s_waitcnt lgkmcnt(" #n ")" ::: "memory")
#define PG8_BAR __builtin_amdgcn_s_barrier()
#define PG8_SCHED __builtin_amdgcn_sched_barrier(0)
    typename Pb::Unit cur, nxt; int ui = 0;
    if (!S.next(0, cur)) return;
    f32x4 acc[2][2][4][2];
#pragma unroll
    for (int a = 0; a < 2; ++a)
#pragma unroll
        for (int b = 0; b < 2; ++b)
#pragma unroll
            for (int m = 0; m < 4; ++m)
#pragma unroll
                for (int n = 0; n < 2; ++n) acc[a][b][m][n] = (f32x4){0.f, 0.f, 0.f, 0.f};
    bf16x8 At[4][2], B0[2][2], B1[2][2];
    unsigned aoc[2][2], aon[2][2];
    S.a_offs(cur, R, C, aoc);
    { const char* b0 = S.b_ptr(cur, 0); const char* b1 = S.b_ptr(cur, 1);
      PG8_STAGE_B(PG8_SB(0, 0), b0); PG8_STAGE_B(PG8_SB(0, 1), b0 + hstepB); PG8_STAGE_A(PG8_SA(0, 0), abase, aoc[0][0], aoc[0][1]); PG8_STAGE_A(PG8_SA(0, 1), abase, aoc[1][0], aoc[1][1]);
      if (wr == 1) PG8_BAR;
      PG8_WAIT_V(2); PG8_BAR;
      PG8_STAGE_B(PG8_SB(1, 0), b1); PG8_STAGE_A(PG8_SA(1, 0), abase + 128, aoc[0][0], aoc[0][1]); PG8_STAGE_B(PG8_SB(1, 1), b1 + hstepB);
      PG8_WAIT_V(6); PG8_BAR; }
    for (;;) {
        const bool has_next = S.next(ui + 1, nxt);
        if (has_next) S.a_offs(nxt, R, C, aon); else { nxt = cur; aon[0][0] = aoc[0][0]; aon[0][1] = aoc[0][1]; aon[1][0] = aoc[1][0]; aon[1][1] = aoc[1][1]; }
        for (int t = 0; t < nt; t += 2) {
            const bool last = (t == nt - 2);
            const char* ak1 = abase + (size_t)(t + 1) * 128;
            const char* ak2 = last ? abase : abase + (size_t)(t + 2) * 128;
            const char* ak3 = ak2 + 128;
            const char* b2 = last ? S.b_ptr(nxt, 0) : S.b_ptr(cur, t + 2); const char* b3 = last ? S.b_ptr(nxt, 1) : S.b_ptr(cur, t + 3);
            const unsigned o00 = last ? aon[0][0] : aoc[0][0], o01 = last ? aon[0][1] : aoc[0][1], o10 = last ? aon[1][0] : aoc[1][0], o11 = last ? aon[1][1] : aoc[1][1];
            PG8_LDB(B0, 0, 0); PG8_LDB(B1, 0, 1); PG8_SCHED; PG8_LDA(At, 0, 0); PG8_STAGE_A(PG8_SA(1, 1), ak1, aoc[1][0], aoc[1][1]);
            PG8_WAIT_V(8); PG8_WAIT_L(0); PG8_BAR; PG8_MMA(0, 0, At, B0); PG8_MMA(0, 1, At, B1); PG8_BAR; PG8_SCHED;
            PG8_LDA(At, 0, 1); PG8_STAGE_B(PG8_SB(0, 0), b2); PG8_STAGE_B(PG8_SB(0, 1), b2 + hstepB); PG8_STAGE_A(PG8_SA(0, 0), ak2, o00, o01);
            PG8_WAIT_V(8); PG8_WAIT_L(0); PG8_BAR; PG8_MMA(1, 0, At, B0); PG8_MMA(1, 1, At, B1); PG8_BAR; PG8_SCHED;
            PG8_LDB(B0, 1, 0); PG8_LDB(B1, 1, 1); PG8_SCHED; PG8_LDA(At, 1, 0); PG8_STAGE_A(PG8_SA(0, 1), ak2, o10, o11);
            PG8_WAIT_V(8); PG8_WAIT_L(0); PG8_BAR; PG8_MMA(0, 0, At, B0); PG8_MMA(0, 1, At, B1); PG8_BAR; PG8_SCHED;
            PG8_LDA(At, 1, 1); PG8_STAGE_B(PG8_SB(1, 0), b3); PG8_STAGE_B(PG8_SB(1, 1), b3 + hstepB); PG8_STAGE_A(PG8_SA(1, 0), ak3, o00, o01);
            PG8_WAIT_V(8); PG8_WAIT_L(0); PG8_BAR; PG8_MMA(1, 0, At, B0); PG8_MMA(1, 1, At, B1); PG8_BAR; PG8_SCHED;
        }
        if constexpr (ALIGN_EPI) { if (wr == 0) PG8_BAR; }
        E(acc, cur, wr, wc, fr, fq);
        if (!has_next) break;
#pragma unroll
        for (int a = 0; a < 2; ++a)
#pragma unroll
            for (int b = 0; b < 2; ++b)
#pragma unroll
                for (int m = 0; m < 4; ++m)
#pragma unroll
                    for (int n = 0; n < 2; ++n) acc[a][b][m][n] = (f32x4){0.f, 0.f, 0.f, 0.f};
        cur = nxt; aoc[0][0] = aon[0][0]; aoc[0][1] = aon[0][1]; aoc[1][0] = aon[1][0]; aoc[1][1] = aon[1][1]; ++ui;
        if constexpr (ALIGN_EPI) { if (wr == 1) PG8_BAR; }
    }
    PG8_WAIT_V(0);
    if constexpr (!ALIGN_EPI) { if (wr == 0) PG8_BAR; }
    PG8_BAR;
#undef PG8_SA
#undef PG8_SB
#undef PG8_STAGE_A
#undef PG8_STAGE_B
#undef PG8_LDA
#undef PG8_LDB
#undef PG8_MMA
#undef PG8_WAIT_V
#undef PG8_WAIT_L
#undef PG8_BAR
#undef PG8_SCHED
}

struct DUnit { int pm, pn; };
struct PbDense {
    typedef DUnit Unit;
    const char* A; const char* Bt; int lda, ldb_, K; StaticOrder so;
    __device__ void init(const void* A_, int lda_, const void* Bt_, int ldb__, int M, int N, int K_) { A = (const char*)A_; Bt = (const char*)Bt_; lda = lda_; ldb_ = ldb__; K = K_; so.init(M, N, gridDim.x, blockIdx.x); }
    __device__ __forceinline__ bool next(int i, Unit& u) const { return so.next(i, u.pm, u.pn); }
    __device__ __forceinline__ int nt() const { return K / BK; }
    __device__ __forceinline__ const char* a_base() const { return A; }
    __device__ __forceinline__ unsigned ldb() const { return (unsigned)ldb_; }
    __device__ __forceinline__ void a_offs(const Unit& u, const int (&R)[2], const int (&C)[2], unsigned (&o)[2][2]) const {
#pragma unroll
        for (int h = 0; h < 2; ++h)
#pragma unroll
            for (int i = 0; i < 2; ++i) o[h][i] = (unsigned)((u.pm * BM + h * HALF + R[i]) * lda + C[i]) * 2u; }
    __device__ __forceinline__ const char* b_ptr(const Unit& u, int t) const { return Bt + (size_t)u.pn * BM * ldb_ * 2 + (size_t)t * 128; }
};
}

__device__ __forceinline__ void ssq_add(float* ssq, int row, float s, int fq) { s += __shfl_xor(s, 16); s += __shfl_xor(s, 32); if (fq == 0) atomicAdd(ssq + row, s); }
__device__ __forceinline__ float sq4(const f32x4& v) { return (v[0] * v[0] + v[1] * v[1]) + (v[2] * v[2] + v[3] * v[3]); }
__device__ __forceinline__ u32x4 pack8(const f32x4& a, const f32x4& b) { u32x4 w; w.x = pg8::cvt_pk_bf16(a[0], a[1]); w.y = pg8::cvt_pk_bf16(a[2], a[3]); w.z = pg8::cvt_pk_bf16(b[0], b[1]); w.w = pg8::cvt_pk_bf16(b[2], b[3]); return w; }
__device__ __forceinline__ void unpack8(const u32x4& w, f32x4& a, f32x4& b) {
    a[0] = __uint_as_float(w.x << 16); a[1] = __uint_as_float(w.x & 0xffff0000u); a[2] = __uint_as_float(w.y << 16); a[3] = __uint_as_float(w.y & 0xffff0000u);
    b[0] = __uint_as_float(w.z << 16); b[1] = __uint_as_float(w.z & 0xffff0000u); b[2] = __uint_as_float(w.w << 16); b[3] = __uint_as_float(w.w & 0xffff0000u); }

struct EpiProj { static constexpr bool PERM = true; bf16_t* proj; const float* rstd;
    __device__ __forceinline__ void operator()(const f32x4 (&acc)[2][2][4][2], const pg8::DUnit& u, int wr, int wc, int fr, int fq) const {
        const int row0 = u.pm * 256 + wr * 64 + fr, col0 = u.pn * 256 + wc * 32 + 8 * fq; const float sc = (u.pn == 0) ? 0.125f : 1.0f;
#pragma unroll
        for (int ai = 0; ai < 2; ++ai)
#pragma unroll
            for (int m = 0; m < 4; ++m) { const int row = row0 + ai * 128 + m * 16; const float s = rstd[row] * sc; bf16_t* rp = proj + (size_t)row * NPROJ + col0;
#pragma unroll
                for (int bj = 0; bj < 2; ++bj) *(u32x4*)(rp + bj * 128) = pack8(acc[ai][bj][m][0] * s, acc[ai][bj][m][1] * s); } } };
__device__ __forceinline__ void phase_alow(const Ptrs& P, int tid) {
    const int lane = tid & 63, gw = blockIdx.x * 8 + (tid >> 6), ngw = gridDim.x * 8;
    const bf16_t* xb = (const bf16_t*)(P.ws + WS_RB); const bf16_t* wa = (const bf16_t*)(P.ws + WS_WA); const float* rstd1 = (const float*)(P.ws + WS_RSTD1); float* alow = (float*)(P.ws + WS_ALOW);
    for (int m = gw; m < T; m += ngw) {
        float acc[LR];
#pragma unroll
        for (int j = 0; j < LR; ++j) acc[j] = 0.f;
        for (int k = lane; k < D; k += 64) { const float xv = bf2f(xb[(size_t)m * D + k]);
#pragma unroll
            for (int j = 0; j < LR; ++j) acc[j] += xv * bf2f(wa[j * D + k]); }
#pragma unroll
        for (int j = 0; j < LR; ++j) { const float s = wave_sum(acc[j]); if (lane == j) alow[(size_t)m * LR + j] = s * rstd1[m]; }
    }
}

__device__ __forceinline__ void phase_gla_naive(const Ptrs& P, int tid) {
    const int lane = tid & 63, gw = blockIdx.x * 8 + (tid >> 6);
    if (gw >= NB * H * DV) return;
    const int bh = gw >> 7, e = gw & 127, b = bh >> 2, h = bh & 3;
    const bf16_t* proj = (const bf16_t*)(P.ws + WS_PROJ); const float* alow = (const float*)(P.ws + WS_ALOW); float* obuf = (float*)(P.ws + WS_RB);
    float wg[LR];
#pragma unroll
    for (int r = 0; r < LR; ++r) wg[r] = P.w_gla_gate[r * QK + h * DK + lane];
    const float bg = P.b_gla_gate[h * DK + lane];
    float st = 0.f;
    for (int t = 0; t < S; ++t) {
        const size_t m = (size_t)b * S + t;
        float z = bg;
#pragma unroll
        for (int r = 0; r < LR; ++r) z += alow[m * LR + r] * wg[r];
        const float a = __expf(logsigmoidf_(z) * (1.f / 16.f));
        const float kv = bf2f(proj[m * NPROJ + PK + h * DK + lane]), qv = bf2f(proj[m * NPROJ + PQ + h * DK + lane]), vv = bf2f(proj[m * NPROJ + PV + h * DV + e]);
        st = a * st + kv * vv;
        const float o = wave_sum(qv * st);
        if (lane == 0) obuf[m * GV + h * DV + e] = o;
    }
}
__device__ __forceinline__ void phase_mix_post(const Ptrs& P, int tid) {
    const int lane = tid & 63, gw = blockIdx.x * 8 + (tid >> 6), ngw = gridDim.x * 8;
    const bf16_t* proj = (const bf16_t*)(P.ws + WS_PROJ); const float* obuf = (const float*)(P.ws + WS_RB); bf16_t* y = (bf16_t*)(P.ws + WS_Y);
    for (int m = gw; m < T; m += ngw) {
#pragma unroll
        for (int h = 0; h < H; ++h) {
            const float o0 = obuf[(size_t)m * GV + h * DV + lane], o1 = obuf[(size_t)m * GV + h * DV + 64 + lane];
            const float ss = wave_sum(o0 * o0 + o1 * o1), r = rsqrtf(ss * (1.f / DV) + EPS);
            const float g0 = bf2f(proj[(size_t)m * NPROJ + PG + h * DV + lane]), g1 = bf2f(proj[(size_t)m * NPROJ + PG + h * DV + 64 + lane]);
            y[(size_t)m * D + h * DV + lane] = f2bf(o0 * r * P.g_gla_out[lane] * siluf_(g0));
            y[(size_t)m * D + h * DV + 64 + lane] = f2bf(o1 * r * P.g_gla_out[64 + lane] * siluf_(g1));
        }
        const int t = m % S;
        for (int c = lane; c < CW; c += 64) {
            float acc = 0.f;
#pragma unroll
            for (int j = 0; j < 3; ++j) { const int tt = t - 2 + j; if (tt >= 0) { const size_t mm = (size_t)m - 2 + j;
                acc += P.w_conv[j * CW + c] * (bf2f(proj[mm * NPROJ + PC + c]) * bf2f(proj[mm * NPROJ + PU + c])); } }
            y[(size_t)m * D + GV + c] = f2bf(bf2f(proj[(size_t)m * NPROJ + PB + c]) * acc);
        }
    }
}
struct EpiOut { static constexpr bool PERM = true; const float* x; bf16_t* x1; float* ssq;
    __device__ __forceinline__ void operator()(const f32x4 (&acc)[2][2][4][2], const pg8::DUnit& u, int wr, int wc, int fr, int fq) const {
        const int row0 = u.pm * 256 + wr * 64 + fr, col0 = u.pn * 256 + wc * 32 + 8 * fq;
#pragma unroll
        for (int ai = 0; ai < 2; ++ai)
#pragma unroll
            for (int m = 0; m < 4; ++m) { const int row = row0 + ai * 128 + m * 16; const size_t off = (size_t)row * D + col0; float sq = 0.f;
#pragma unroll
                for (int bj = 0; bj < 2; ++bj) { const f32x4 r0 = *(const f32x4*)(x + off + bj * 128) + acc[ai][bj][m][0], r1 = *(const f32x4*)(x + off + bj * 128 + 4) + acc[ai][bj][m][1];
                    sq += sq4(r0) + sq4(r1); *(u32x4*)(x1 + off + bj * 128) = pack8(r0, r1); }
                ssq_add(ssq, row, sq, fq); } } };
__device__ __forceinline__ void phase_route(const Ptrs& P, int tid) {
    const int lane = tid & 63, gw = blockIdx.x * 8 + (tid >> 6), ngw = gridDim.x * 8;
    const bf16_t* x1 = (const bf16_t*)(P.ws + WS_RB); const float* WR = (const float*)(P.ws + WS_WR); const float* ssq2 = (const float*)(P.ws + WS_SSQ2);
    TokInfo* ti = (TokInfo*)(P.ws + WS_TOKI); int* lists = (int*)(P.ws + WS_LIST); unsigned* cnt = (unsigned*)(P.ws + WS_CTL);
    for (int m = gw; m < T; m += ngw) {
        float acc[20];
#pragma unroll
        for (int j = 0; j < 20; ++j) acc[j] = 0.f;
        for (int k = lane; k < D; k += 64) { const float xv = bf2f(x1[(size_t)m * D + k]);
#pragma unroll
            for (int j = 0; j < 20; ++j) acc[j] += xv * WR[j * D + k]; }
#pragma unroll
        for (int j = 0; j < 20; ++j) acc[j] = wave_sum(acc[j]);
        if (lane == 0) {
            const float rstd = rsqrtf(ssq2[m] * (1.f / D) + EPS);
            float gl[4]; int gs = 0;
#pragma unroll
            for (int j = 0; j < 4; ++j) gl[j] = acc[j] * rstd + P.b_group[j];
            float gbest = gl[0];
#pragma unroll
            for (int j = 1; j < 4; ++j) if (gl[j] > gbest) { gbest = gl[j]; gs = j; }
            float den = 0.f;
#pragma unroll
            for (int j = 0; j < 4; ++j) den += __expf(gl[j] - gbest);
            const float pgrp = 1.f / den;
            float el[4];
#pragma unroll
            for (int j = 0; j < 4; ++j) { float v = 0.f;
#pragma unroll
                for (int g = 0; g < 4; ++g) if (g == gs) v = acc[4 + g * 4 + j] * rstd + P.b_router[g * 4 + j];
                el[j] = v; }
            int i0 = 0; float v0 = el[0];
#pragma unroll
            for (int j = 1; j < 4; ++j) if (el[j] > v0) { v0 = el[j]; i0 = j; }
            int i1 = -1; float v1 = -3.0e38f;
#pragma unroll
            for (int j = 0; j < 4; ++j) if (j != i0 && el[j] > v1) { v1 = el[j]; i1 = j; }
            const float e1 = __expf(v1 - v0);
            const float w0 = pgrp / (1.f + e1), w1 = pgrp * e1 / (1.f + e1);
            const int lo = i0 < i1 ? i0 : i1, hi = i0 < i1 ? i1 : i0;
            const int pidx = (lo == 0) ? (hi - 1) : (lo == 1 ? (hi + 1) : 5);
            const int cat = gs * 6 + pidx;
            TokInfo info; info.cat = cat; info.w_lo = (i0 < i1) ? w0 : w1; info.w_hi = (i0 < i1) ? w1 : w0; info.rstd = rstd;
            ti[m] = info;
            const unsigned slot = atomicAdd(cnt + cat, 1u);
            lists[(size_t)cat * T + slot] = m;
        }
    }
}
__device__ __forceinline__ void cat_experts(int cat, int& e_lo, int& e_hi) {
    const int g = cat / 6, p = cat % 6; int lo, hi;
    if (p < 3) { lo = 0; hi = p + 1; } else if (p < 5) { lo = 1; hi = p - 1; } else { lo = 2; hi = 3; }
    e_lo = g * 4 + lo; e_hi = g * 4 + hi;
}
__device__ __forceinline__ bool rowtile_lookup(const unsigned* cnt, int rt, int& cat, int& slot0, int& n) {
    int base = 0;
    for (int c = 0; c < NCAT; ++c) { const int nc = (int)__hip_atomic_load(cnt + c, __ATOMIC_RELAXED, __HIP_MEMORY_SCOPE_AGENT), ntile = (nc + 255) >> 8; if (rt < base + ntile) { cat = c; slot0 = (rt - base) * 256; n = nc; return true; } base += ntile; }
    cat = 0; slot0 = 0; n = 0; return false;
}
struct MUnit { int rt, pn, cat, slot0, n, e_lo, e_hi; };
struct PbMoe1 {
    typedef MUnit Unit;
    const char* X1; const char* W1; const int* lists; const unsigned* cnt; int G, c;
    __device__ __forceinline__ bool next(int i, Unit& u) const { const int L = i * G + c; u.rt = L >> 3; u.pn = L & 7; if (!rowtile_lookup(cnt, u.rt, u.cat, u.slot0, u.n)) return false; cat_experts(u.cat, u.e_lo, u.e_hi); return true; }
    __device__ __forceinline__ int nt() const { return D / 64; }
    __device__ __forceinline__ const char* a_base() const { return X1; }
    __device__ __forceinline__ unsigned ldb() const { return (unsigned)D; }
    __device__ __forceinline__ void a_offs(const Unit& u, const int (&R)[2], const int (&C)[2], unsigned (&o)[2][2]) const {
        const int* list = lists + (size_t)u.cat * T;
#pragma unroll
        for (int h = 0; h < 2; ++h)
#pragma unroll
            for (int i = 0; i < 2; ++i) { int sl = u.slot0 + h * 128 + R[i]; if (sl >= u.n) sl = u.slot0; o[h][i] = (unsigned)(list[sl] * D + C[i]) * 2u; } }
    __device__ __forceinline__ const char* b_ptr(const Unit& u, int t) const { const int e = (u.pn >> 2) ? u.e_hi : u.e_lo; return W1 + ((size_t)e * D + (size_t)(u.pn & 3) * 256) * D * 2 + (size_t)t * 128; }
};
struct EpiHid { static constexpr bool PERM = true; bf16_t* hid; const TokInfo* ti; const int* lists;
    __device__ __forceinline__ void operator()(const f32x4 (&acc)[2][2][4][2], const MUnit& u, int wr, int wc, int fr, int fq) const {
        const int* list = lists + (size_t)u.cat * T; const int kx = u.pn >> 2, col0 = kx * 512 + (u.pn & 3) * 128 + wc * 32 + 8 * fq;
#pragma unroll
        for (int ai = 0; ai < 2; ++ai)
#pragma unroll
            for (int m = 0; m < 4; ++m) { const int rl = ai * 128 + wr * 64 + m * 16 + fr, sl = u.slot0 + rl;
                if (sl < u.n) { const TokInfo t = ti[list[sl]]; const float w = kx ? t.w_hi : t.w_lo; f32x4 o[2];
#pragma unroll
                    for (int n = 0; n < 2; ++n)
#pragma unroll
                        for (int j = 0; j < 4; ++j) { const float g = acc[ai][0][m][n][j] * t.rstd, up = acc[ai][1][m][n][j] * t.rstd; o[n][j] = siluf_(g) * up * w; }
                    *(u32x4*)(hid + (size_t)(u.rt * 256 + rl) * D + col0) = pack8(o[0], o[1]); } } } };
__device__ __forceinline__ void phase_moe1(const Ptrs& P, LAS unsigned char* lds) {
    PbMoe1 pb{(const char*)(P.ws + WS_RB), (const char*)(P.ws + WS_W1), (const int*)(P.ws + WS_LIST), (const unsigned*)(P.ws + WS_CTL), (int)gridDim.x, (int)blockIdx.x};
    EpiHid ep{(bf16_t*)(P.ws + WS_HID), (const TokInfo*)(P.ws + WS_TOKI), (const int*)(P.ws + WS_LIST)};
    pg8::gemm_phase<PbMoe1, EpiHid, true>(lds, pb, ep);
}
struct PbMoe2 {
    typedef MUnit Unit;
    const char* HID; const char* W2; const unsigned* cnt; int G, c;
    __device__ __forceinline__ bool next(int i, Unit& u) const { const int L = i * G + c; u.rt = L >> 2; u.pn = L & 3; if (!rowtile_lookup(cnt, u.rt, u.cat, u.slot0, u.n)) return false; cat_experts(u.cat, u.e_lo, u.e_hi); return true; }
    __device__ __forceinline__ int nt() const { return D / 64; }
    __device__ __forceinline__ const char* a_base() const { return HID; }
    __device__ __forceinline__ unsigned ldb() const { return 2048u; }
    __device__ __forceinline__ void a_offs(const Unit& u, const int (&R)[2], const int (&C)[2], unsigned (&o)[2][2]) const {
#pragma unroll
        for (int h = 0; h < 2; ++h)
#pragma unroll
            for (int i = 0; i < 2; ++i) o[h][i] = (unsigned)((u.rt * 256 + h * 128 + R[i]) * D + C[i]) * 2u; }
    __device__ __forceinline__ const char* b_ptr(const Unit& u, int t) const {
        const int g = u.e_lo >> 2, el = (t < 8) ? (u.e_lo & 3) : (u.e_hi & 3);
        return W2 + ((size_t)g * D + (size_t)u.pn * 256) * 2048 * 2 + (size_t)el * 1024 + (size_t)(t & 7) * 128; }
};
struct EpiX2 { static constexpr bool PERM = true; const bf16_t* x1; bf16_t* x2; float* ssq; const int* lists;
    __device__ __forceinline__ void operator()(const f32x4 (&acc)[2][2][4][2], const MUnit& u, int wr, int wc, int fr, int fq) const {
        const int* list = lists + (size_t)u.cat * T; const int col0 = u.pn * 256 + wc * 32 + 8 * fq;
#pragma unroll
        for (int ai = 0; ai < 2; ++ai)
#pragma unroll
            for (int m = 0; m < 4; ++m) { const int rl = ai * 128 + wr * 64 + m * 16 + fr, sl = u.slot0 + rl; const bool v = sl < u.n; const int tok = list[v ? sl : u.slot0];
                const size_t off = (size_t)tok * D + col0; float sq = 0.f;
#pragma unroll
                for (int bj = 0; bj < 2; ++bj) { f32x4 r0, r1; unpack8(*(const u32x4*)(x1 + off + bj * 128), r0, r1); r0 += acc[ai][bj][m][0]; r1 += acc[ai][bj][m][1];
                    sq += sq4(r0) + sq4(r1); if (v) *(u32x4*)(x2 + off + bj * 128) = pack8(r0, r1); }
                sq += __shfl_xor(sq, 16); sq += __shfl_xor(sq, 32); if (fq == 0 && v) atomicAdd(ssq + tok, sq); } } };
__device__ __forceinline__ void phase_moe2(const Ptrs& P, LAS unsigned char* lds) {
    PbMoe2 pb{(const char*)(P.ws + WS_HID), (const char*)(P.ws + WS_W2), (const unsigned*)(P.ws + WS_CTL), (int)gridDim.x, (int)blockIdx.x};
    EpiX2 ep{(const bf16_t*)(P.ws + WS_RB), (bf16_t*)(P.ws + WS_X2), (float*)(P.ws + WS_SSQ3), (const int*)(P.ws + WS_LIST)};
    pg8::gemm_phase<PbMoe2, EpiX2, true>(lds, pb, ep);
}
struct EpiPP { static constexpr bool PERM = true; bf16_t* pp;
    __device__ __forceinline__ void operator()(const f32x4 (&acc)[2][2][4][2], const pg8::DUnit& u, int wr, int wc, int fr, int fq) const {
        const int row0 = u.pm * 256 + wr * 64 + fr, col0 = u.pn * 256 + wc * 32 + 8 * fq;
#pragma unroll
        for (int ai = 0; ai < 2; ++ai)
#pragma unroll
            for (int m = 0; m < 4; ++m) { bf16_t* rp = pp + (size_t)(row0 + ai * 128 + m * 16) * D + col0;
#pragma unroll
                for (int bj = 0; bj < 2; ++bj) *(u32x4*)(rp + bj * 128) = pack8(acc[ai][bj][m][0], acc[ai][bj][m][1]); } } };
struct EpiPle { static constexpr bool PERM = true; const bf16_t* x2; const bf16_t* pp; const float* ssq3; bf16_t* x3; float* ssq4;
    __device__ __forceinline__ void operator()(const f32x4 (&acc)[2][2][4][2], const pg8::DUnit& u, int wr, int wc, int fr, int fq) const {
        const int row0 = u.pm * 256 + wr * 64 + fr, col0 = u.pn * 256 + wc * 32 + 8 * fq;
#pragma unroll
        for (int ai = 0; ai < 2; ++ai)
#pragma unroll
            for (int m = 0; m < 4; ++m) { const int row = row0 + ai * 128 + m * 16; const size_t off = (size_t)row * D + col0; float sq = 0.f;
                const float rstd = rsqrtf(__hip_atomic_load(ssq3 + row, __ATOMIC_RELAXED, __HIP_MEMORY_SCOPE_AGENT) * (1.f / D) + EPS);
#pragma unroll
                for (int bj = 0; bj < 2; ++bj) { f32x4 a0, a1, p0, p1; unpack8(*(const u32x4*)(x2 + off + bj * 128), a0, a1); unpack8(*(const u32x4*)(pp + off + bj * 128), p0, p1);
#pragma unroll
                    for (int j = 0; j < 4; ++j) { a0[j] += sigmoidf_(acc[ai][bj][m][0][j] * rstd) * p0[j]; a1[j] += sigmoidf_(acc[ai][bj][m][1][j] * rstd) * p1[j]; }
                    sq += sq4(a0) + sq4(a1); *(u32x4*)(x3 + off + bj * 128) = pack8(a0, a1); }
                ssq_add(ssq4, row, sq, fq); } } };
__device__ __forceinline__ void phase_final(const Ptrs& P, int tid) {
    const int lane = tid & 63, gw = blockIdx.x * 8 + (tid >> 6), ngw = gridDim.x * 8;
    const bf16_t* x3 = (const bf16_t*)(P.ws + WS_X3); const float* ssq4 = (const float*)(P.ws + WS_SSQ4);
    for (int m = gw; m < T; m += ngw) {
        const float rstd = rsqrtf(ssq4[m] * (1.f / D) + EPS);
        for (int c = lane; c < D; c += 64) P.out[(size_t)m * D + c] = bf2f(x3[(size_t)m * D + c]) * rstd * P.g_final[c];
    }
}

__global__ void __launch_bounds__(NTHREADS, 2) mega_fwd(Ptrs P) {
    extern __shared__ __attribute__((aligned(16))) unsigned char lds_raw[];
    LAS unsigned char* lds = (LAS unsigned char*)lds_raw;
    const int tid = threadIdx.x;
    LAS unsigned* lctl = (LAS unsigned*)(lds + LDSCTL_OFF);
    for (int u = tid; u < 64; u += NTHREADS) lctl[u] = 0u;
    __syncthreads();
    XcdBarrier bar = xcd_barrier_post((unsigned*)(P.ws + WS_CTL) + CW_BAR, (volatile LAS unsigned*)(lctl + 8));

    phase_prep(P, lds, tid);
    xcd_barrier(bar);
    { pg8::PbDense pb; pb.init(P.ws + WS_RB, D, P.ws + WS_WIN, D, T, NPROJ, D); EpiProj ep{(bf16_t*)(P.ws + WS_PROJ), (const float*)(P.ws + WS_RSTD1)};
      pg8::gemm_phase<pg8::PbDense, EpiProj, true>(lds, pb, ep); }
    phase_alow(P, tid);
    xcd_barrier(bar);
    phase_gla_naive(P, tid);
    xcd_barrier(bar);
    phase_mix_post(P, tid);
    xcd_barrier(bar);
    { pg8::PbDense pb; pb.init(P.ws + WS_Y, D, P.ws + WS_WOUT, D, T, D, D); EpiOut ep{P.x, (bf16_t*)(P.ws + WS_RB), (float*)(P.ws + WS_SSQ2)};
      pg8::gemm_phase<pg8::PbDense, EpiOut, true>(lds, pb, ep); }
    xcd_barrier(bar);
    phase_route(P, tid);
    xcd_barrier(bar);
    phase_moe1(P, lds);
    { pg8::PbDense pb; pb.init(P.ws + WS_PB, DPLE, P.ws + WS_WPP, DPLE, T, D, DPLE); EpiPP ep{(bf16_t*)(P.ws + WS_Y)};
      pg8::gemm_phase<pg8::PbDense, EpiPP, true>(lds, pb, ep); }
    xcd_barrier(bar);
    phase_moe2(P, lds);
    xcd_barrier(bar);
    { pg8::PbDense pb; pb.init(P.ws + WS_X2, D, P.ws + WS_WPG, D, T, D, D);
      EpiPle ep{(const bf16_t*)(P.ws + WS_X2), (const bf16_t*)(P.ws + WS_Y), (const float*)(P.ws + WS_SSQ3), (bf16_t*)(P.ws + WS_X3), (float*)(P.ws + WS_SSQ4)};
      pg8::gemm_phase<pg8::PbDense, EpiPle, true>(lds, pb, ep); }
    xcd_barrier(bar);
    phase_final(P, tid);
}

extern "C" void kernel_launch(void* const* d_in, const int* in_sizes, int n_in, void* d_out, int out_size, void* d_ws, size_t ws_size, hipStream_t stream) {
    static int grid = 0;
    if (grid == 0) {
        if (n_in != 21 || in_sizes[0] != T * D || out_size != T * D || ws_size < WS_END) {
            fprintf(stderr, "kernel_launch: unexpected shapes: n_in %d in0 %d out %d ws %zu\n", n_in, n_in > 0 ? in_sizes[0] : -1, out_size, ws_size); grid = -1; return; }
        int dev = 0, cus = 0, per_cu = 0;
        if (hipGetDevice(&dev) != hipSuccess || hipDeviceGetAttribute(&cus, hipDeviceAttributeMultiprocessorCount, dev) != hipSuccess) { grid = -1; return; }
        if (hipFuncSetAttribute((const void*)mega_fwd, hipFuncAttributeMaxDynamicSharedMemorySize, LDS_BYTES) != hipSuccess) { fprintf(stderr, "kernel_launch: hipFuncSetAttribute failed\n"); grid = -1; return; }
        if (hipOccupancyMaxActiveBlocksPerMultiprocessor(&per_cu, (const void*)mega_fwd, NTHREADS, LDS_BYTES) != hipSuccess || per_cu < 1) {
            fprintf(stderr, "kernel_launch: occupancy query says %d workgroups per CU; not launching\n", per_cu); grid = -1; return; }
        (void)hipGetLastError();
        grid = cus;
    }
    if (grid < 0) return;
    Ptrs P{};
    const float** pp = (const float**)&P;
    for (int i = 0; i < 21; ++i) pp[i] = (const float*)d_in[i];
    P.out = (float*)d_out; P.ws = (unsigned char*)d_ws;
    if (hipMemsetAsync((char*)d_ws + WS_CTL, 0, CTL_BYTES, stream) != hipSuccess) { fprintf(stderr, "kernel_launch: memset failed\n"); return; }
    hipLaunchKernelGGL(mega_fwd, dim3(grid), dim3(NTHREADS), LDS_BYTES, stream, P);
}
```

```cpp
#include <hip/hip_runtime.h>
#include <cstdio>
#include <cstdint>

typedef unsigned short bf16_t;
typedef short bf16x8 __attribute__((ext_vector_type(8)));
typedef float f32x4 __attribute__((ext_vector_type(4)));
typedef unsigned u32x4 __attribute__((ext_vector_type(4)));
typedef unsigned u32x2 __attribute__((ext_vector_type(2)));
#define LAS __attribute__((address_space(3)))

constexpr int D = 1024, NB = 2, S = 8192, T = NB * S, DPLE = 256;
constexpr int H = 4, DK = 64, DV = 128, LR = 16, QK = 256, GV = 512, CW = 512;
constexpr int DIN = 3088, NPROJ = 3072;
constexpr int NE = 16, DE = 512, NCAT = 24;
constexpr float EPS = 1e-6f;
constexpr int PQ = 0, PK = 256, PV = 512, PG = 1024, PB = 1536, PC = 2048, PU = 2560;
constexpr int MAXRT = 88;
constexpr int NTHREADS = 512;

constexpr size_t MiB = 1u << 20;
constexpr size_t WS_CTL = 0, CTL_BYTES = 1 * MiB;
constexpr int CW_BAR = 4096;
constexpr size_t WS_SSQ2 = 256 * 1024;
constexpr size_t WS_SSQ3 = WS_SSQ2 + 64 * 1024;
constexpr size_t WS_SSQ4 = WS_SSQ3 + 64 * 1024;
constexpr size_t WS_WIN = 1 * MiB;
constexpr size_t WS_WOUT = 7 * MiB;
constexpr size_t WS_WPG = 9 * MiB;
constexpr size_t WS_WPP = 11 * MiB;
constexpr size_t WS_WA = 11 * MiB + 512 * 1024;
constexpr size_t WS_WR = 11 * MiB + 768 * 1024;
constexpr size_t WS_W1 = 12 * MiB;
constexpr size_t WS_W2 = 44 * MiB;
constexpr size_t WS_SMALL = 60 * MiB;
constexpr size_t WS_RSTD1 = WS_SMALL;
constexpr size_t WS_ALOW = WS_SMALL + 64 * 1024;
constexpr size_t WS_TOKI = WS_ALOW + 1 * MiB;
constexpr size_t WS_LIST = WS_TOKI + 256 * 1024;
constexpr size_t WS_DEC = 63 * MiB;
constexpr size_t WS_ST = 232 * MiB;
constexpr size_t WS_RB = 64 * MiB;
constexpr size_t WS_PB = 96 * MiB;
constexpr size_t WS_PROJ = 104 * MiB;
constexpr size_t WS_HID = WS_PROJ;
constexpr size_t WS_X2 = WS_PROJ + 44 * MiB;
constexpr size_t WS_Y = 200 * MiB;
constexpr size_t WS_X3 = WS_RB;
constexpr size_t WS_END = 256 * MiB;
static_assert(WS_LIST + (size_t)NCAT * T * 4 <= WS_RB, "small arrays fit");
static_assert(WS_Y + (size_t)T * D * 2 <= WS_END && WS_X2 + (size_t)T * D * 2 <= WS_Y, "map");

constexpr int LDS_BYTES = 147456;
constexpr int LDSCTL_OFF = 131072;

struct TokInfo { int cat; float w_lo, w_hi, rstd; };

__device__ __forceinline__ float bf2f(bf16_t v) { return __uint_as_float(((unsigned)v) << 16); }
__device__ __forceinline__ bf16_t f2bf(float f) { unsigned u = __float_as_uint(f); return (bf16_t)((u + 0x7fffu + ((u >> 16) & 1u)) >> 16); }
__device__ __forceinline__ unsigned pk2(float lo, float hi) { return (unsigned)f2bf(lo) | ((unsigned)f2bf(hi) << 16); }
__device__ __forceinline__ float wave_sum(float v) {
#pragma unroll
    for (int o = 1; o < 64; o <<= 1) v += __shfl_xor(v, o);
    return v;
}
__device__ __forceinline__ float sigmoidf_(float x) { return 1.0f / (1.0f + __expf(-x)); }
__device__ __forceinline__ float siluf_(float x) { return x * sigmoidf_(x); }
__device__ __forceinline__ float logsigmoidf_(float x) { return fminf(x, 0.f) - log1pf(__expf(-fabsf(x))); }

struct Ptrs {
    const float *x, *p, *g_mix, *w_in, *w_gla_gate, *b_gla_gate, *g_gla_out, *w_conv, *w_out, *g_moe, *w_group, *b_group, *w_router, *b_router,
        *w_exp_gate, *w_exp_up, *w_exp_down, *g_ple, *w_ple_gate, *w_ple_proj, *g_final;
    float* out; unsigned char* ws;
};

#define XB_TMO      128
#define XB_XCNT(j)  (256  + 64 * (j))
#define XB_XSUB(j)  (1280 + 64 * (j))
#define XB_XGEN(j)  (2304 + 64 * (j))
#define XB_TOP      3328
#define XB_TOPGEN   3392
#define XCD_BAR_WORDS 3456
#define XB_SPIN_CAP (1u << 18)
__device__ __forceinline__ unsigned xb_ld(unsigned* p)              { return __hip_atomic_load(p, __ATOMIC_RELAXED, __HIP_MEMORY_SCOPE_AGENT); }
__device__ __forceinline__ unsigned xb_add(unsigned* p, unsigned v) { return __hip_atomic_fetch_add(p, v, __ATOMIC_RELAXED, __HIP_MEMORY_SCOPE_AGENT); }
__device__ __forceinline__ unsigned xb_xcc_id() { return (unsigned)__builtin_amdgcn_s_getreg((3 << 11) | 20) & 0xFu; }
#define XB_SPIN(cond, bar) do { unsigned _sp = 0; while (cond) { __builtin_amdgcn_s_sleep(1); \
    if ((++_sp & 255u) == 0u) { if (xb_ld(&(bar)[XB_TMO])) break; if (_sp > XB_SPIN_CAP) { atomicAdd(&(bar)[XB_TMO], 1u); break; } } } } while (0)
struct XcdBarrier { unsigned* bar; unsigned x; volatile LAS unsigned* st; };
__device__ __forceinline__ XcdBarrier xcd_barrier_post(unsigned* bar, volatile LAS unsigned* st) {
    XcdBarrier b; b.bar = bar; b.x = xb_xcc_id(); b.st = st;
    if (threadIdx.x == 0) (void)xb_add(&bar[XB_XCNT(b.x)], 1u);
    return b;
}
__device__ __forceinline__ void xcd_barrier_complete(unsigned* bar, unsigned x, unsigned& nloc, unsigned& nx) {
    const unsigned G = gridDim.x * gridDim.y * gridDim.z;
    unsigned sum, cnt, mine, sp = 0u;
    for (;;) {
        sum = 0u; cnt = 0u; mine = 0u;
#pragma unroll
        for (unsigned j = 0; j < 16; ++j) { const unsigned c = xb_ld(&bar[XB_XCNT(j)]); sum += c; cnt += (c > 0u) ? 1u : 0u; mine = (j == x) ? c : mine; }
        if (sum == G) break;
        __builtin_amdgcn_s_sleep(1);
        if ((++sp & 255u) == 0u) { if (xb_ld(&bar[XB_TMO])) break; if (sp > XB_SPIN_CAP) { atomicAdd(&bar[XB_TMO], 1u); break; } }
    }
    nloc = mine > 0u ? mine : 1u; nx = cnt > 0u ? cnt : 1u;
}
__device__ __forceinline__ void xcd_barrier(const XcdBarrier& b) {
    asm volatile("s_waitcnt vmcnt(0)" ::: "memory");
    __syncthreads();
    if (threadIdx.x == 0) {
        unsigned* bar = b.bar;
        __builtin_amdgcn_s_waitcnt(0);
        unsigned nloc = b.st[0], nx = b.st[1];
        if (nloc == 0u) { xcd_barrier_complete(bar, b.x, nloc, nx); b.st[0] = nloc; b.st[1] = nx; }
        const unsigned old = xb_add(&bar[XB_XSUB(b.x)], 1u);
        const unsigned gen = old / nloc;
        if (old + 1u == (gen + 1u) * nloc) {
            __builtin_amdgcn_fence(__ATOMIC_RELEASE, "agent");
            asm volatile("s_waitcnt vmcnt(0)" ::: "memory");
            const unsigned og = xb_add(&bar[XB_TOP], 1u);
            const unsigned tg = og / nx;
            if (og + 1u == (tg + 1u) * nx) xb_add(&bar[XB_TOPGEN], 1u);
            else XB_SPIN(xb_ld(&bar[XB_TOPGEN]) == tg, bar);
            __builtin_amdgcn_fence(__ATOMIC_ACQUIRE, "agent");
            xb_add(&bar[XB_XGEN(b.x)], 1u);
            asm volatile("s_waitcnt vmcnt(0)" ::: "memory");
        } else {
            XB_SPIN(xb_ld(&bar[XB_XGEN(b.x)]) == gen, bar);
            __builtin_amdgcn_fence(__ATOMIC_ACQUIRE, "agent");
            asm volatile("s_waitcnt vmcnt(0)" ::: "memory");
        }
    }
    __syncthreads();
}

struct WJob { const float* src; int src_ld; const float* gain; bf16_t* dst; int dst_ld; int K, N; int mode; };
constexpr int NJOBS = 5 + 32 + 16;
__device__ __forceinline__ WJob get_job(const Ptrs& P, int j) {
    WJob w;
    if (j == 0) { w = WJob{P.w_in, DIN, P.g_mix, (bf16_t*)(P.ws + WS_WIN), D, D, NPROJ, 1}; }
    else if (j == 1) { w = WJob{P.w_in + 1536, DIN, P.g_mix, (bf16_t*)(P.ws + WS_WA), D, D, LR, 0}; }
    else if (j == 2) { w = WJob{P.w_out, D, nullptr, (bf16_t*)(P.ws + WS_WOUT), D, D, D, 0}; }
    else if (j == 3) { w = WJob{P.w_ple_gate, D, P.g_ple, (bf16_t*)(P.ws + WS_WPG), D, D, D, 0}; }
    else if (j == 4) { w = WJob{P.w_ple_proj, D, nullptr, (bf16_t*)(P.ws + WS_WPP), DPLE, DPLE, D, 0}; }
    else if (j < 37) { const int jj = j - 5, e = jj >> 1, half = jj & 1;
        w = WJob{(half ? P.w_exp_up : P.w_exp_gate) + (size_t)e * D * DE, DE, P.g_moe, (bf16_t*)(P.ws + WS_W1) + (size_t)e * D * D, D, D, DE, 2 + half}; }
    else { const int e = j - 37, g = e >> 2, el = e & 3;
        w = WJob{P.w_exp_down + (size_t)e * DE * D, D, nullptr, (bf16_t*)(P.ws + WS_W2) + (size_t)g * D * 2048 + el * DE, 2048, DE, D, 0}; }
    return w;
}
__device__ __forceinline__ int job_tiles(const WJob& w) { return ((w.N + 31) / 32) * (w.K / 32); }
__device__ __forceinline__ void transpose_tile(const WJob& w, int tile, bool valid, LAS float* tl, int gt) {
    const int nkt = w.K / 32, nt = tile / nkt, kt = tile % nkt, n0 = nt * 32, k0 = kt * 32;
    const int tx = gt & 31, ty = gt >> 5;
#pragma unroll
    for (int i = 0; i < 4; ++i) { const int kk = ty + 8 * i, n = n0 + tx; float v = 0.f;
        if (valid && n < w.N) { const int col = (w.mode == 1) ? (n < 1536 ? n : n + 16) : n; v = w.src[(size_t)(k0 + kk) * w.src_ld + col]; if (w.gain) v *= w.gain[k0 + kk]; }
        tl[kk * 33 + tx] = v; }
    __syncthreads();
#pragma unroll
    for (int i = 0; i < 4; ++i) { const int nn = ty + 8 * i, n = n0 + nn;
        if (valid && n < w.N) { const int row = (w.mode >= 2) ? (((n >> 7) << 8) + (w.mode - 2) * 128 + (n & 127)) : n;
            w.dst[(size_t)row * w.dst_ld + k0 + tx] = f2bf(tl[tx * 33 + nn]); } }
    __syncthreads();
}
__device__ __forceinline__ void phase_prep(const Ptrs& P, LAS unsigned char* lds, int tid) {
    const int grp = tid >> 8, gt = tid & 255; LAS float* tl = (LAS float*)lds + grp * (32 * 33);
    const int G2 = gridDim.x * 2, me = blockIdx.x * 2 + grp;
    int base = 0;
    for (int j = 0; j < NJOBS; ++j) { const WJob w = get_job(P, j); const int nt = job_tiles(w);
        const int first = ((me - base % G2) + G2) % G2; const int rounds = (nt + G2 - 1) / G2 + 1;
        for (int r = 0; r < rounds; ++r) { const int t = first + r * G2; transpose_tile(w, t < nt ? t : 0, t < nt, tl, gt); }
        base += nt; }
    float* WR = (float*)(P.ws + WS_WR);
    for (int i = blockIdx.x * NTHREADS + tid; i < 20 * D; i += gridDim.x * NTHREADS) { const int j = i / D, k = i % D;
        WR[i] = P.g_moe[k] * (j < 4 ? P.w_group[k * 4 + j] : P.w_router[k * NE + (j - 4)]); }
    const int lane = tid & 63, gw = blockIdx.x * 8 + (tid >> 6), ngw = gridDim.x * 8;
    bf16_t* xb = (bf16_t*)(P.ws + WS_RB); float* rstd1 = (float*)(P.ws + WS_RSTD1); bf16_t* pb = (bf16_t*)(P.ws + WS_PB);
    for (int m = gw; m < T; m += ngw) {
        const f32x4* xr = (const f32x4*)(P.x + (size_t)m * D) + lane; f32x4 v[4]; float s = 0.f;
#pragma unroll
        for (int j = 0; j < 4; ++j) { v[j] = xr[64 * j]; s += (v[j].x * v[j].x + v[j].y * v[j].y) + (v[j].z * v[j].z + v[j].w * v[j].w); }
        s = wave_sum(s);
        if (lane == 0) rstd1[m] = rsqrtf(s * (1.f / D) + EPS);
        u32x2* o = (u32x2*)(xb + (size_t)m * D) + lane;
#pragma unroll
        for (int j = 0; j < 4; ++j) { u32x2 w; w.x = pk2(v[j].x, v[j].y); w.y = pk2(v[j].z, v[j].w); o[64 * j] = w; }
        const f32x4 pv = ((const f32x4*)(P.p + (size_t)m * DPLE))[lane]; u32x2 w; w.x = pk2(pv.x, pv.y); w.y = pk2(pv.z, pv.w);
        ((u32x2*)(pb + (size_t)m * DPLE))[lane] = w;
    }
}

namespace pg8 {
constexpr int BM = 256, BK = 64, HALF = 128, HTB = HALF * BK * 2, STAGE_BYTES = 8 * HTB, NXCD = 8, WGM = 8;
__device__ __forceinline__ int lds_byte(int r, int c) { const int st = (r >> 4) * 2 + (c >> 5), rr = r & 15, cc = c & 31, ob = rr * 64 + cc * 2; return st * 1024 + (ob ^ (((ob >> 9) & 1) << 5)); }
__device__ __forceinline__ void stage_rc(int b, int& R, int& C) { const int st = b / 1024, sb = b % 1024, swz = sb ^ (((sb >> 9) & 1) << 5); R = (st >> 1) * 16 + swz / 64; C = (st & 1) * 32 + (swz % 64) / 2; }
__device__ __forceinline__ int perm32(int rho) { const int n = rho >> 4, i = rho & 15; return 8 * (i >> 2) + 4 * n + (i & 3); }
__device__ __forceinline__ unsigned cvt_pk_bf16(float lo, float hi) { unsigned r; asm volatile("v_cvt_pk_bf16_f32 %0, %1, %2" : "=v"(r) : "v"(lo), "v"(hi)); return r; }

struct StaticOrder {
    int nM, nN, nwg, G, c;
    __device__ void init(int M, int N, int G_, int c_) { nM = M / BM; nN = N / BM; nwg = nM * nN; G = G_; c = c_; }
    __device__ bool next(int i, int& pm, int& pn) const {
        const long L = (long)i * G + c; if (L >= nwg) return false;
        int wgid = (int)L; { const int q = nwg / NXCD, r = nwg % NXCD, xcd = wgid % NXCD, off = wgid / NXCD; wgid = (xcd < r ? xcd * (q + 1) : r * (q + 1) + (xcd - r) * q) + off; }
        const int nig = WGM * nN, gid = wgid / nig, fm = gid * WGM, gsz = (nM - fm) < WGM ? (nM - fm) : WGM;
        pm = fm + ((wgid % nig) % gsz); pn = (wgid % nig) / gsz; return true;
    }
};

template <class Pb, class Epi, bool ALIGN_EPI>
__device__ __forceinline__ void gemm_phase(LAS unsigned char* lds, const Pb& S, const Epi& E) {
    const int tid = threadIdx.x, wid = __builtin_amdgcn_readfirstlane(tid >> 6), lane = tid & 63, wr = wid >> 2, wc = wid & 3, fr = lane & 15, fq = lane >> 4;
    const int nt = S.nt();
    int R[2], C[2]; unsigned voffB[2];
#pragma unroll
    for (int i = 0; i < 2; ++i) { stage_rc(tid * 16 + i * 8192, R[i], C[i]); const int Rb = Epi::PERM ? ((R[i] & ~31) + perm32(R[i] & 31)) : R[i]; voffB[i] = (unsigned)(Rb * (int)S.ldb() + C[i]) * 2u; }
    const size_t hstepB = (size_t)HALF * S.ldb() * 2;
    const unsigned ldsw = (unsigned)wid * 1024u;
    const int aoff = lds_byte(wr * 64 + fr, fq * 8), boff = lds_byte(wc * 32 + fr, fq * 8);
    const char* const abase = S.a_base();
#define PG8_SA(b, h) (((b) * 2 + (h)) * HTB)
#define PG8_SB(b, h) ((4 + (b) * 2 + (h)) * HTB)
#define PG8_STAGE_B(bufoff, gbase) do { _Pragma("unroll") for (int _i = 0; _i < 2; ++_i) \
        __builtin_amdgcn_global_load_lds((const unsigned*)((const char*)(gbase) + voffB[_i]), (LAS unsigned*)(lds + (bufoff) + ldsw + _i * 8192), 16, 0, 0); } while (0)
#define PG8_STAGE_A(bufoff, kbase, o0, o1) do { \
        __builtin_amdgcn_global_load_lds((const unsigned*)((kbase) + (o0)), (LAS unsigned*)(lds + (bufoff) + ldsw), 16, 0, 0); \
        __builtin_amdgcn_global_load_lds((const unsigned*)((kbase) + (o1)), (LAS unsigned*)(lds + (bufoff) + ldsw + 8192), 16, 0, 0); } while (0)
#define PG8_LDA(dst, b, h) do { _Pragma("unroll") for (int m = 0; m < 4; ++m) _Pragma("unroll") for (int k = 0; k < 2; ++k) dst[m][k] = *(const LAS bf16x8*)(lds + PG8_SA(b, h) + aoff + m * 2048 + k * 1024); } while (0)
#define PG8_LDB(dst, b, h) do { _Pragma("unroll") for (int n = 0; n < 2; ++n) _Pragma("unroll") for (int k = 0; k < 2; ++k) dst[n][k] = *(const LAS bf16x8*)(lds + PG8_SB(b, h) + boff + n * 2048 + k * 1024); } while (0)
#define PG8_MMA(ai, bj, At, Bt) do { __builtin_amdgcn_s_setprio(1); _Pragma("unroll") for (int m = 0; m < 4; ++m) _Pragma("unroll") for (int n = 0; n < 2; ++n) _Pragma("unroll") for (int k = 0; k < 2; ++k) \
        acc[ai][bj][m][n] = __builtin_amdgcn_mfma_f32_16x16x32_bf16(Bt[n][k], At[m][k], acc[ai][bj][m][n], 0, 0, 0); __builtin_amdgcn_s_setprio(0); } while (0)
#define PG8_WAIT_V(n) asm volatile("s_waitcnt vmcnt(" #n ")" ::: "memory")
#define PG8_WAIT_L(n) asm volatile("s_waitcnt lgkmcnt(" #n ")" ::: "memory")
#define PG8_BAR __builtin_amdgcn_s_barrier()
#define PG8_SCHED __builtin_amdgcn_sched_barrier(0)
    typename Pb::Unit cur, nxt; int ui = 0;
    if (!S.next(0, cur)) return;
    f32x4 acc[2][2][4][2];
#pragma unroll
    for (int a = 0; a < 2; ++a)
#pragma unroll
        for (int b = 0; b < 2; ++b)
#pragma unroll
            for (int m = 0; m < 4; ++m)
#pragma unroll
                for (int n = 0; n < 2; ++n) acc[a][b][m][n] = (f32x4){0.f, 0.f, 0.f, 0.f};
    bf16x8 At[4][2], B0[2][2], B1[2][2];
    unsigned aoc[2][2], aon[2][2];
    S.a_offs(cur, R, C, aoc);
    { const char* b0 = S.b_ptr(cur, 0); const char* b1 = S.b_ptr(cur, 1);
      PG8_STAGE_B(PG8_SB(0, 0), b0); PG8_STAGE_B(PG8_SB(0, 1), b0 + hstepB); PG8_STAGE_A(PG8_SA(0, 0), abase, aoc[0][0], aoc[0][1]); PG8_STAGE_A(PG8_SA(0, 1), abase, aoc[1][0], aoc[1][1]);
      if (wr == 1) PG8_BAR;
      PG8_WAIT_V(2); PG8_BAR;
      PG8_STAGE_B(PG8_SB(1, 0), b1); PG8_STAGE_A(PG8_SA(1, 0), abase + 128, aoc[0][0], aoc[0][1]); PG8_STAGE_B(PG8_SB(1, 1), b1 + hstepB);
      PG8_WAIT_V(6); PG8_BAR; }
    for (;;) {
        const bool has_next = S.next(ui + 1, nxt);
        if (has_next) S.a_offs(nxt, R, C, aon); else { nxt = cur; aon[0][0] = aoc[0][0]; aon[0][1] = aoc[0][1]; aon[1][0] = aoc[1][0]; aon[1][1] = aoc[1][1]; }
        for (int t = 0; t < nt; t += 2) {
            const bool last = (t == nt - 2);
            const char* ak1 = abase + (size_t)(t + 1) * 128;
            const char* ak2 = last ? abase : abase + (size_t)(t + 2) * 128;
            const char* ak3 = ak2 + 128;
            const char* b2 = last ? S.b_ptr(nxt, 0) : S.b_ptr(cur, t + 2); const char* b3 = last ? S.b_ptr(nxt, 1) : S.b_ptr(cur, t + 3);
            const unsigned o00 = last ? aon[0][0] : aoc[0][0], o01 = last ? aon[0][1] : aoc[0][1], o10 = last ? aon[1][0] : aoc[1][0], o11 = last ? aon[1][1] : aoc[1][1];
            PG8_LDB(B0, 0, 0); PG8_LDB(B1, 0, 1); PG8_SCHED; PG8_LDA(At, 0, 0); PG8_STAGE_A(PG8_SA(1, 1), ak1, aoc[1][0], aoc[1][1]);
            PG8_WAIT_V(8); PG8_WAIT_L(0); PG8_BAR; PG8_MMA(0, 0, At, B0); PG8_MMA(0, 1, At, B1); PG8_BAR; PG8_SCHED;
            PG8_LDA(At, 0, 1); PG8_STAGE_B(PG8_SB(0, 0), b2); PG8_STAGE_B(PG8_SB(0, 1), b2 + hstepB); PG8_STAGE_A(PG8_SA(0, 0), ak2, o00, o01);
            PG8_WAIT_V(8); PG8_WAIT_L(0); PG8_BAR; PG8_MMA(1, 0, At, B0); PG8_MMA(1, 1, At, B1); PG8_BAR; PG8_SCHED;
            PG8_LDB(B0, 1, 0); PG8_LDB(B1, 1, 1); PG8_SCHED; PG8_LDA(At, 1, 0); PG8_STAGE_A(PG8_SA(0, 1), ak2, o10, o11);
            PG8_WAIT_V(8); PG8_WAIT_L(0); PG8_BAR; PG8_MMA(0, 0, At, B0); PG8_MMA(0, 1, At, B1); PG8_BAR; PG8_SCHED;
            PG8_LDA(At, 1, 1); PG8_STAGE_B(PG8_SB(1, 0), b3); PG8_STAGE_B(PG8_SB(1, 1), b3 + hstepB); PG8_STAGE_A(PG8_SA(1, 0), ak3, o00, o01);
            PG8_WAIT_V(8); PG8_WAIT_L(0); PG8_BAR; PG8_MMA(1, 0, At, B0); PG8_MMA(1, 1, At, B1); PG8_BAR; PG8_SCHED;
        }
        if constexpr (ALIGN_EPI) { if (wr == 0) PG8_BAR; }
        E(acc, cur, wr, wc, fr, fq);
        if (!has_next) break;
#pragma unroll
        for (int a = 0; a < 2; ++a)
#pragma unroll
            for (int b = 0; b < 2; ++b)
#pragma unroll
                for (int m = 0; m < 4; ++m)
#pragma unroll
                    for (int n = 0; n < 2; ++n) acc[a][b][m][n] = (f32x4){0.f, 0.f, 0.f, 0.f};
        cur = nxt; aoc[0][0] = aon[0][0]; aoc[0][1] = aon[0][1]; aoc[1][0] = aon[1][0]; aoc[1][1] = aon[1][1]; ++ui;
        if constexpr (ALIGN_EPI) { if (wr == 1) PG8_BAR; }
    }
    PG8_WAIT_V(0);
    if constexpr (!ALIGN_EPI) { if (wr == 0) PG8_BAR; }
    PG8_BAR;
#undef PG8_SA
#undef PG8_SB
#undef PG8_STAGE_A
#undef PG8_STAGE_B
#undef PG8_LDA
#undef PG8_LDB
#undef PG8_MMA
#undef PG8_WAIT_V
#undef PG8_WAIT_L
#undef PG8_BAR
#undef PG8_SCHED
}

struct DUnit { int pm, pn; };
struct PbDense {
    typedef DUnit Unit;
    const char* A; const char* Bt; int lda, ldb_, K; StaticOrder so;
    __device__ void init(const void* A_, int lda_, const void* Bt_, int ldb__, int M, int N, int K_) { A = (const char*)A_; Bt = (const char*)Bt_; lda = lda_; ldb_ = ldb__; K = K_; so.init(M, N, gridDim.x, blockIdx.x); }
    __device__ __forceinline__ bool next(int i, Unit& u) const { return so.next(i, u.pm, u.pn); }
    __device__ __forceinline__ int nt() const { return K / BK; }
    __device__ __forceinline__ const char* a_base() const { return A; }
    __device__ __forceinline__ unsigned ldb() const { return (unsigned)ldb_; }
    __device__ __forceinline__ void a_offs(const Unit& u, const int (&R)[2], const int (&C)[2], unsigned (&o)[2][2]) const {
#pragma unroll
        for (int h = 0; h < 2; ++h)
#pragma unroll
            for (int i = 0; i < 2; ++i) o[h][i] = (unsigned)((u.pm * BM + h * HALF + R[i]) * lda + C[i]) * 2u; }
    __device__ __forceinline__ const char* b_ptr(const Unit& u, int t) const { return Bt + (size_t)u.pn * BM * ldb_ * 2 + (size_t)t * 128; }
};
}

__device__ __forceinline__ void ssq_add(float* ssq, int row, float s, int fq) { s += __shfl_xor(s, 16); s += __shfl_xor(s, 32); if (fq == 0) atomicAdd(ssq + row, s); }
__device__ __forceinline__ float sq4(const f32x4& v) { return (v[0] * v[0] + v[1] * v[1]) + (v[2] * v[2] + v[3] * v[3]); }
__device__ __forceinline__ u32x4 pack8(const f32x4& a, const f32x4& b) { u32x4 w; w.x = pg8::cvt_pk_bf16(a[0], a[1]); w.y = pg8::cvt_pk_bf16(a[2], a[3]); w.z = pg8::cvt_pk_bf16(b[0], b[1]); w.w = pg8::cvt_pk_bf16(b[2], b[3]); return w; }
__device__ __forceinline__ void unpack8(const u32x4& w, f32x4& a, f32x4& b) {
    a[0] = __uint_as_float(w.x << 16); a[1] = __uint_as_float(w.x & 0xffff0000u); a[2] = __uint_as_float(w.y << 16); a[3] = __uint_as_float(w.y & 0xffff0000u);
    b[0] = __uint_as_float(w.z << 16); b[1] = __uint_as_float(w.z & 0xffff0000u); b[2] = __uint_as_float(w.w << 16); b[3] = __uint_as_float(w.w & 0xffff0000u); }

struct EpiProj { static constexpr bool PERM = true; bf16_t* proj; const float* rstd;
    __device__ __forceinline__ void operator()(const f32x4 (&acc)[2][2][4][2], const pg8::DUnit& u, int wr, int wc, int fr, int fq) const {
        const int row0 = u.pm * 256 + wr * 64 + fr, col0 = u.pn * 256 + wc * 32 + 8 * fq; const float sc = (u.pn == 0) ? 0.125f : 1.0f;
#pragma unroll
        for (int ai = 0; ai < 2; ++ai)
#pragma unroll
            for (int m = 0; m < 4; ++m) { const int row = row0 + ai * 128 + m * 16; const float s = rstd[row] * sc; bf16_t* rp = proj + (size_t)row * NPROJ + col0;
#pragma unroll
                for (int bj = 0; bj < 2; ++bj) *(u32x4*)(rp + bj * 128) = pack8(acc[ai][bj][m][0] * s, acc[ai][bj][m][1] * s); } } };
__device__ __forceinline__ void phase_alow(const Ptrs& P, int tid) {
    const int lane = tid & 63, gw = blockIdx.x * 8 + (tid >> 6), ngw = gridDim.x * 8;
    const bf16_t* xb = (const bf16_t*)(P.ws + WS_RB); const bf16_t* wa = (const bf16_t*)(P.ws + WS_WA); const float* rstd1 = (const float*)(P.ws + WS_RSTD1); float* alow = (float*)(P.ws + WS_ALOW);
    for (int m = gw; m < T; m += ngw) {
        float acc[LR];
#pragma unroll
        for (int j = 0; j < LR; ++j) acc[j] = 0.f;
        for (int k = lane; k < D; k += 64) { const float xv = bf2f(xb[(size_t)m * D + k]);
#pragma unroll
            for (int j = 0; j < LR; ++j) acc[j] += xv * bf2f(wa[j * D + k]); }
#pragma unroll
        for (int j = 0; j < LR; ++j) { const float s = wave_sum(acc[j]); if (lane == j) alow[(size_t)m * LR + j] = s * rstd1[m]; }
    }
}

constexpr int LROW = 72;
__device__ __forceinline__ void phase_gla_a(const Ptrs& P, LAS unsigned char* lds, int tid) {
    const int lane = tid & 63, wid = tid >> 6, fr = lane & 15, fq = lane >> 4, d = lane, tg = wid;
    LAS float* s_alow = (LAS float*)lds;
    LAS float* s_tot = (LAS float*)(lds + 4096);
    LAS bf16_t* s_kd = (LAS bf16_t*)(lds + 8192);
    LAS bf16_t* s_vt = (LAS bf16_t*)(lds + 8192 + 64 * LROW * 2);
    bf16_t* proj = (bf16_t*)(P.ws + WS_PROJ); const float* alow = (const float*)(P.ws + WS_ALOW); float* sloc = (float*)(P.ws + WS_RB); float* dec = (float*)(P.ws + WS_DEC);
    for (int item = blockIdx.x; item < NB * H * (S / 64); item += gridDim.x) {
        const int bh = item >> 7, c = item & 127, b = bh >> 2, h = bh & 3; const size_t tok0 = (size_t)b * S + (size_t)c * 64;
        float wg[LR];
#pragma unroll
        for (int r = 0; r < LR; ++r) wg[r] = P.w_gla_gate[r * QK + h * DK + d];
        const float bg = P.b_gla_gate[h * DK + d];
        for (int i = tid; i < 64 * LR; i += NTHREADS) s_alow[i] = alow[tok0 * LR + i];
        float kv[8], qv[8];
#pragma unroll
        for (int j = 0; j < 8; ++j) { const size_t m = tok0 + tg * 8 + j; kv[j] = bf2f(proj[m * NPROJ + PK + h * DK + d]); qv[j] = bf2f(proj[m * NPROJ + PQ + h * DK + d]); }
        u32x4 vv[2];
#pragma unroll
        for (int i = 0; i < 2; ++i) { const int id = tid + i * NTHREADS; vv[i] = *(const u32x4*)(proj + (tok0 + (id >> 4)) * NPROJ + PV + h * DV + (id & 15) * 8); }
        __syncthreads();
        float cum[8]; float run = 0.f;
#pragma unroll
        for (int j = 0; j < 8; ++j) { const int t = tg * 8 + j; float z = bg;
#pragma unroll
            for (int r = 0; r < LR; ++r) z += s_alow[t * LR + r] * wg[r];
            run += logsigmoidf_(z) * (1.f / 16.f); cum[j] = run; }
        s_tot[tg * 64 + d] = run;
        __syncthreads();
        float pre = 0.f, last = 0.f;
#pragma unroll
        for (int g = 0; g < 8; ++g) { const float v = s_tot[g * 64 + d]; last += v; if (g < tg) pre += v; }
#pragma unroll
        for (int j = 0; j < 8; ++j) { const int t = tg * 8 + j; const size_t m = tok0 + t; const float cm = cum[j] + pre;
            proj[m * NPROJ + PQ + h * DK + d] = f2bf(qv[j] * __expf(cm)); proj[m * NPROJ + PK + h * DK + d] = f2bf(kv[j] * __expf(-cm));
            s_kd[d * LROW + t] = f2bf(kv[j] * __expf(last - cm)); }
#pragma unroll
        for (int i = 0; i < 2; ++i) { const int id = tid + i * NTHREADS, t = id >> 4, e0 = (id & 15) * 8;
            s_vt[(e0 + 0) * LROW + t] = (bf16_t)(vv[i].x & 0xffffu); s_vt[(e0 + 1) * LROW + t] = (bf16_t)(vv[i].x >> 16);
            s_vt[(e0 + 2) * LROW + t] = (bf16_t)(vv[i].y & 0xffffu); s_vt[(e0 + 3) * LROW + t] = (bf16_t)(vv[i].y >> 16);
            s_vt[(e0 + 4) * LROW + t] = (bf16_t)(vv[i].z & 0xffffu); s_vt[(e0 + 5) * LROW + t] = (bf16_t)(vv[i].z >> 16);
            s_vt[(e0 + 6) * LROW + t] = (bf16_t)(vv[i].w & 0xffffu); s_vt[(e0 + 7) * LROW + t] = (bf16_t)(vv[i].w >> 16); }
        if (tg == 0) dec[(size_t)item * DK + d] = __expf(last);
        __syncthreads();
#pragma unroll
        for (int dt = 0; dt < 4; ++dt) { f32x4 acc = (f32x4){0.f, 0.f, 0.f, 0.f};
#pragma unroll
            for (int kk = 0; kk < 2; ++kk) { const bf16x8 a = *(const LAS bf16x8*)(s_kd + (dt * 16 + fr) * LROW + kk * 32 + fq * 8), bq = *(const LAS bf16x8*)(s_vt + (wid * 16 + fr) * LROW + kk * 32 + fq * 8);
                acc = __builtin_amdgcn_mfma_f32_16x16x32_bf16(a, bq, acc, 0, 0, 0); }
            *(f32x4*)(sloc + (size_t)item * (DK * DV) + (size_t)(wid * 16 + fr) * DK + dt * 16 + 4 * fq) = acc; }
        __syncthreads();
    }
}
__device__ __forceinline__ void phase_gla_b(const Ptrs& P, int tid) {
    const int nb_scan = gridDim.x / 2;
    if ((int)blockIdx.x < nb_scan) {
        const float* sloc = (const float*)(P.ws + WS_RB); const float* dec = (const float*)(P.ws + WS_DEC); bf16_t* st = (bf16_t*)(P.ws + WS_ST);
        for (int gt = blockIdx.x * NTHREADS + tid; gt < NB * H * DK * DV; gt += nb_scan * NTHREADS) {
            const int bh = gt >> 13, idx = gt & 8191, d = idx & 63; float sv = 0.f;
#pragma unroll 8
            for (int c = 0; c < S / 64; ++c) { const size_t item = (size_t)bh * (S / 64) + c;
                st[item * (DK * DV) + idx] = f2bf(sv); sv = dec[item * DK + d] * sv + sloc[item * (DK * DV) + idx]; }
        }
    } else {
        const bf16_t* proj = (const bf16_t*)(P.ws + WS_PROJ); bf16_t* y = (bf16_t*)(P.ws + WS_Y);
        const int nth = (gridDim.x - nb_scan) * NTHREADS;
        for (int id = (blockIdx.x - nb_scan) * NTHREADS + tid; id < T * (CW / 8); id += nth) {
            const int tok = id >> 6, c0 = (id & 63) * 8, t = tok & (S - 1);
            f32x4 a0 = (f32x4){0.f, 0.f, 0.f, 0.f}, a1 = a0;
#pragma unroll
            for (int j = 0; j < 3; ++j) { if (t - 2 + j >= 0) { const size_t mm = (size_t)tok - 2 + j; f32x4 c_0, c_1, u_0, u_1;
                unpack8(*(const u32x4*)(proj + mm * NPROJ + PC + c0), c_0, c_1); unpack8(*(const u32x4*)(proj + mm * NPROJ + PU + c0), u_0, u_1);
                const f32x4 w0 = *(const f32x4*)(P.w_conv + j * CW + c0), w1 = *(const f32x4*)(P.w_conv + j * CW + c0 + 4);
                a0 += w0 * (c_0 * u_0); a1 += w1 * (c_1 * u_1); } }
            f32x4 b0, b1; unpack8(*(const u32x4*)(proj + (size_t)tok * NPROJ + PB + c0), b0, b1);
            *(u32x4*)(y + (size_t)tok * D + GV + c0) = pack8(b0 * a0, b1 * a1);
        }
    }
}
__device__ __forceinline__ void phase_gla_c(const Ptrs& P, LAS unsigned char* lds, int tid) {
    const int lane = tid & 63, wid = tid >> 6, fr = lane & 15, fq = lane >> 4;
    LAS bf16_t* s_q = (LAS bf16_t*)lds;
    LAS bf16_t* s_k = (LAS bf16_t*)(lds + 9216);
    LAS bf16_t* s_vt = (LAS bf16_t*)(lds + 18432);
    LAS bf16_t* s_st = (LAS bf16_t*)(lds + 36864);
    LAS bf16_t* s_p = (LAS bf16_t*)(lds + 55296);
    LAS float* s_red = (LAS float*)(lds + 64512);
    const bf16_t* proj = (const bf16_t*)(P.ws + WS_PROJ); const bf16_t* st = (const bf16_t*)(P.ws + WS_ST); bf16_t* y = (bf16_t*)(P.ws + WS_Y);
    const int tt = wid >> 1, wh = wid & 1;
    for (int item = blockIdx.x; item < NB * H * (S / 64); item += gridDim.x) {
        const int bh = item >> 7, c = item & 127, b = bh >> 2, h = bh & 3; const size_t tok0 = (size_t)b * S + (size_t)c * 64;
        { const int row = tid >> 3, ch = tid & 7;
          *(LAS u32x4*)(s_q + row * LROW + ch * 8) = *(const u32x4*)(proj + (tok0 + row) * NPROJ + PQ + h * DK + ch * 8);
          *(LAS u32x4*)(s_k + row * LROW + ch * 8) = *(const u32x4*)(proj + (tok0 + row) * NPROJ + PK + h * DK + ch * 8); }
#pragma unroll
        for (int i = 0; i < 2; ++i) { const int id = tid + i * NTHREADS, row = id >> 3, ch = id & 7;
            *(LAS u32x4*)(s_st + row * LROW + ch * 8) = *(const u32x4*)(st + (size_t)item * (DK * DV) + row * DK + ch * 8); }
#pragma unroll
        for (int i = 0; i < 2; ++i) { const int id = tid + i * NTHREADS, t = id >> 4, e0 = (id & 15) * 8;
            const u32x4 vv = *(const u32x4*)(proj + (tok0 + t) * NPROJ + PV + h * DV + e0);
            s_vt[(e0 + 0) * LROW + t] = (bf16_t)(vv.x & 0xffffu); s_vt[(e0 + 1) * LROW + t] = (bf16_t)(vv.x >> 16);
            s_vt[(e0 + 2) * LROW + t] = (bf16_t)(vv.y & 0xffffu); s_vt[(e0 + 3) * LROW + t] = (bf16_t)(vv.y >> 16);
            s_vt[(e0 + 4) * LROW + t] = (bf16_t)(vv.z & 0xffffu); s_vt[(e0 + 5) * LROW + t] = (bf16_t)(vv.z >> 16);
            s_vt[(e0 + 6) * LROW + t] = (bf16_t)(vv.w & 0xffffu); s_vt[(e0 + 7) * LROW + t] = (bf16_t)(vv.w >> 16); }
        __syncthreads();
#pragma unroll
        for (int si = 0; si < 2; ++si) { const int stile = wh * 2 + si; f32x4 acc = (f32x4){0.f, 0.f, 0.f, 0.f};
#pragma unroll
            for (int kk = 0; kk < 2; ++kk) { const bf16x8 a = *(const LAS bf16x8*)(s_k + (stile * 16 + fr) * LROW + kk * 32 + fq * 8), bq = *(const LAS bf16x8*)(s_q + (tt * 16 + fr) * LROW + kk * 32 + fq * 8);
                acc = __builtin_amdgcn_mfma_f32_16x16x32_bf16(a, bq, acc, 0, 0, 0); }
            const int t = tt * 16 + fr, s0 = stile * 16 + 4 * fq;
            u32x2 w; w.x = pk2(s0 + 0 <= t ? acc[0] : 0.f, s0 + 1 <= t ? acc[1] : 0.f); w.y = pk2(s0 + 2 <= t ? acc[2] : 0.f, s0 + 3 <= t ? acc[3] : 0.f);
            *(LAS u32x2*)(s_p + t * LROW + s0) = w; }
        __syncthreads();
        f32x4 o[4]; float sq = 0.f;
#pragma unroll
        for (int ei = 0; ei < 4; ++ei) { const int et = wh * 4 + ei; f32x4 acc = (f32x4){0.f, 0.f, 0.f, 0.f};
#pragma unroll
            for (int kk = 0; kk < 2; ++kk) { const bf16x8 a = *(const LAS bf16x8*)(s_st + (et * 16 + fr) * LROW + kk * 32 + fq * 8), bq = *(const LAS bf16x8*)(s_q + (tt * 16 + fr) * LROW + kk * 32 + fq * 8);
                acc = __builtin_amdgcn_mfma_f32_16x16x32_bf16(a, bq, acc, 0, 0, 0); }
#pragma unroll
            for (int kk = 0; kk < 2; ++kk) { const bf16x8 a = *(const LAS bf16x8*)(s_vt + (et * 16 + fr) * LROW + kk * 32 + fq * 8), bq = *(const LAS bf16x8*)(s_p + (tt * 16 + fr) * LROW + kk * 32 + fq * 8);
                acc = __builtin_amdgcn_mfma_f32_16x16x32_bf16(a, bq, acc, 0, 0, 0); }
            o[ei] = acc; sq += sq4(acc); }
        sq += __shfl_xor(sq, 16); sq += __shfl_xor(sq, 32);
        const int t = tt * 16 + fr;
        if (fq == 0) s_red[t * 2 + wh] = sq;
        __syncthreads();
        const float rstd = rsqrtf((s_red[t * 2] + s_red[t * 2 + 1]) * (1.f / DV) + EPS);
#pragma unroll
        for (int ei = 0; ei < 4; ++ei) { const int e0 = (wh * 4 + ei) * 16 + 4 * fq;
            const u32x2 gw = *(const u32x2*)(proj + (tok0 + t) * NPROJ + PG + h * DV + e0); const f32x4 gg = *(const f32x4*)(P.g_gla_out + e0);
            const float g0 = __uint_as_float(gw.x << 16), g1 = __uint_as_float(gw.x & 0xffff0000u), g2 = __uint_as_float(gw.y << 16), g3 = __uint_as_float(gw.y & 0xffff0000u);
            u32x2 w; w.x = pk2(o[ei][0] * rstd * gg[0] * siluf_(g0), o[ei][1] * rstd * gg[1] * siluf_(g1)); w.y = pk2(o[ei][2] * rstd * gg[2] * siluf_(g2), o[ei][3] * rstd * gg[3] * siluf_(g3));
            *(u32x2*)(y + (tok0 + t) * D + h * DV + e0) = w; }
        __syncthreads();
    }
}
struct EpiOut { static constexpr bool PERM = true; const float* x; bf16_t* x1; float* ssq;
    __device__ __forceinline__ void operator()(const f32x4 (&acc)[2][2][4][2], const pg8::DUnit& u, int wr, int wc, int fr, int fq) const {
        const int row0 = u.pm * 256 + wr * 64 + fr, col0 = u.pn * 256 + wc * 32 + 8 * fq;
#pragma unroll
        for (int ai = 0; ai < 2; ++ai)
#pragma unroll
            for (int m = 0; m < 4; ++m) { const int row = row0 + ai * 128 + m * 16; const size_t off = (size_t)row * D + col0; float sq = 0.f;
#pragma unroll
                for (int bj = 0; bj < 2; ++bj) { const f32x4 r0 = *(const f32x4*)(x + off + bj * 128) + acc[ai][bj][m][0], r1 = *(const f32x4*)(x + off + bj * 128 + 4) + acc[ai][bj][m][1];
                    sq += sq4(r0) + sq4(r1); *(u32x4*)(x1 + off + bj * 128) = pack8(r0, r1); }
                ssq_add(ssq, row, sq, fq); } } };
__device__ __forceinline__ void phase_route(const Ptrs& P, int tid) {
    const int lane = tid & 63, gw = blockIdx.x * 8 + (tid >> 6), ngw = gridDim.x * 8;
    const bf16_t* x1 = (const bf16_t*)(P.ws + WS_RB); const float* WR = (const float*)(P.ws + WS_WR); const float* ssq2 = (const float*)(P.ws + WS_SSQ2);
    TokInfo* ti = (TokInfo*)(P.ws + WS_TOKI); int* lists = (int*)(P.ws + WS_LIST); unsigned* cnt = (unsigned*)(P.ws + WS_CTL);
    for (int m = gw; m < T; m += ngw) {
        float acc[20];
#pragma unroll
        for (int j = 0; j < 20; ++j) acc[j] = 0.f;
        for (int k = lane; k < D; k += 64) { const float xv = bf2f(x1[(size_t)m * D + k]);
#pragma unroll
            for (int j = 0; j < 20; ++j) acc[j] += xv * WR[j * D + k]; }
#pragma unroll
        for (int j = 0; j < 20; ++j) acc[j] = wave_sum(acc[j]);
        if (lane == 0) {
            const float rstd = rsqrtf(ssq2[m] * (1.f / D) + EPS);
            float gl[4]; int gs = 0;
#pragma unroll
            for (int j = 0; j < 4; ++j) gl[j] = acc[j] * rstd + P.b_group[j];
            float gbest = gl[0];
#pragma unroll
            for (int j = 1; j < 4; ++j) if (gl[j] > gbest) { gbest = gl[j]; gs = j; }
            float den = 0.f;
#pragma unroll
            for (int j = 0; j < 4; ++j) den += __expf(gl[j] - gbest);
            const float pgrp = 1.f / den;
            float el[4];
#pragma unroll
            for (int j = 0; j < 4; ++j) { float v = 0.f;
#pragma unroll
                for (int g = 0; g < 4; ++g) if (g == gs) v = acc[4 + g * 4 + j] * rstd + P.b_router[g * 4 + j];
                el[j] = v; }
            int i0 = 0; float v0 = el[0];
#pragma unroll
            for (int j = 1; j < 4; ++j) if (el[j] > v0) { v0 = el[j]; i0 = j; }
            int i1 = -1; float v1 = -3.0e38f;
#pragma unroll
            for (int j = 0; j < 4; ++j) if (j != i0 && el[j] > v1) { v1 = el[j]; i1 = j; }
            const float e1 = __expf(v1 - v0);
            const float w0 = pgrp / (1.f + e1), w1 = pgrp * e1 / (1.f + e1);
            const int lo = i0 < i1 ? i0 : i1, hi = i0 < i1 ? i1 : i0;
            const int pidx = (lo == 0) ? (hi - 1) : (lo == 1 ? (hi + 1) : 5);
            const int cat = gs * 6 + pidx;
            TokInfo info; info.cat = cat; info.w_lo = (i0 < i1) ? w0 : w1; info.w_hi = (i0 < i1) ? w1 : w0; info.rstd = rstd;
            ti[m] = info;
            const unsigned slot = atomicAdd(cnt + cat, 1u);
            lists[(size_t)cat * T + slot] = m;
        }
    }
}
__device__ __forceinline__ void cat_experts(int cat, int& e_lo, int& e_hi) {
    const int g = cat / 6, p = cat % 6; int lo, hi;
    if (p < 3) { lo = 0; hi = p + 1; } else if (p < 5) { lo = 1; hi = p - 1; } else { lo = 2; hi = 3; }
    e_lo = g * 4 + lo; e_hi = g * 4 + hi;
}
__device__ __forceinline__ bool rowtile_lookup(const unsigned* cnt, int rt, int& cat, int& slot0, int& n) {
    int base = 0;
    for (int c = 0; c < NCAT; ++c) { const int nc = (int)__hip_atomic_load(cnt + c, __ATOMIC_RELAXED, __HIP_MEMORY_SCOPE_AGENT), ntile = (nc + 255) >> 8; if (rt < base + ntile) { cat = c; slot0 = (rt - base) * 256; n = nc; return true; } base += ntile; }
    cat = 0; slot0 = 0; n = 0; return false;
}
struct MUnit { int rt, pn, cat, slot0, n, e_lo, e_hi; };
struct PbMoe1 {
    typedef MUnit Unit;
    const char* X1; const char* W1; const int* lists; const unsigned* cnt; int G, c;
    __device__ __forceinline__ bool next(int i, Unit& u) const { const int L = i * G + c; u.rt = L >> 3; u.pn = L & 7; if (!rowtile_lookup(cnt, u.rt, u.cat, u.slot0, u.n)) return false; cat_experts(u.cat, u.e_lo, u.e_hi); return true; }
    __device__ __forceinline__ int nt() const { return D / 64; }
    __device__ __forceinline__ const char* a_base() const { return X1; }
    __device__ __forceinline__ unsigned ldb() const { return (unsigned)D; }
    __device__ __forceinline__ void a_offs(const Unit& u, const int (&R)[2], const int (&C)[2], unsigned (&o)[2][2]) const {
        const int* list = lists + (size_t)u.cat * T;
#pragma unroll
        for (int h = 0; h < 2; ++h)
#pragma unroll
            for (int i = 0; i < 2; ++i) { int sl = u.slot0 + h * 128 + R[i]; if (sl >= u.n) sl = u.slot0; o[h][i] = (unsigned)(list[sl] * D + C[i]) * 2u; } }
    __device__ __forceinline__ const char* b_ptr(const Unit& u, int t) const { const int e = (u.pn >> 2) ? u.e_hi : u.e_lo; return W1 + ((size_t)e * D + (size_t)(u.pn & 3) * 256) * D * 2 + (size_t)t * 128; }
};
struct EpiHid { static constexpr bool PERM = true; bf16_t* hid; const TokInfo* ti; const int* lists;
    __device__ __forceinline__ void operator()(const f32x4 (&acc)[2][2][4][2], const MUnit& u, int wr, int wc, int fr, int fq) const {
        const int* list = lists + (size_t)u.cat * T; const int kx = u.pn >> 2, col0 = kx * 512 + (u.pn & 3) * 128 + wc * 32 + 8 * fq;
#pragma unroll
        for (int ai = 0; ai < 2; ++ai)
#pragma unroll
            for (int m = 0; m < 4; ++m) { const int rl = ai * 128 + wr * 64 + m * 16 + fr, sl = u.slot0 + rl;
                if (sl < u.n) { const TokInfo t = ti[list[sl]]; const float w = kx ? t.w_hi : t.w_lo; f32x4 o[2];
#pragma unroll
                    for (int n = 0; n < 2; ++n)
#pragma unroll
                        for (int j = 0; j < 4; ++j) { const float g = acc[ai][0][m][n][j] * t.rstd, up = acc[ai][1][m][n][j] * t.rstd; o[n][j] = siluf_(g) * up * w; }
                    *(u32x4*)(hid + (size_t)(u.rt * 256 + rl) * D + col0) = pack8(o[0], o[1]); } } } };
__device__ __forceinline__ void phase_moe1(const Ptrs& P, LAS unsigned char* lds) {
    PbMoe1 pb{(const char*)(P.ws + WS_RB), (const char*)(P.ws + WS_W1), (const int*)(P.ws + WS_LIST), (const unsigned*)(P.ws + WS_CTL), (int)gridDim.x, (int)blockIdx.x};
    EpiHid ep{(bf16_t*)(P.ws + WS_HID), (const TokInfo*)(P.ws + WS_TOKI), (const int*)(P.ws + WS_LIST)};
    pg8::gemm_phase<PbMoe1, EpiHid, true>(lds, pb, ep);
}
struct PbMoe2 {
    typedef MUnit Unit;
    const char* HID; const char* W2; const unsigned* cnt; int G, c;
    __device__ __forceinline__ bool next(int i, Unit& u) const { const int L = i * G + c; u.rt = L >> 2; u.pn = L & 3; if (!rowtile_lookup(cnt, u.rt, u.cat, u.slot0, u.n)) return false; cat_experts(u.cat, u.e_lo, u.e_hi); return true; }
    __device__ __forceinline__ int nt() const { return D / 64; }
    __device__ __forceinline__ const char* a_base() const { return HID; }
    __device__ __forceinline__ unsigned ldb() const { return 2048u; }
    __device__ __forceinline__ void a_offs(const Unit& u, const int (&R)[2], const int (&C)[2], unsigned (&o)[2][2]) const {
#pragma unroll
        for (int h = 0; h < 2; ++h)
#pragma unroll
            for (int i = 0; i < 2; ++i) o[h][i] = (unsigned)((u.rt * 256 + h * 128 + R[i]) * D + C[i]) * 2u; }
    __device__ __forceinline__ const char* b_ptr(const Unit& u, int t) const {
        const int g = u.e_lo >> 2, el = (t < 8) ? (u.e_lo & 3) : (u.e_hi & 3);
        return W2 + ((size_t)g * D + (size_t)u.pn * 256) * 2048 * 2 + (size_t)el * 1024 + (size_t)(t & 7) * 128; }
};
struct EpiX2 { static constexpr bool PERM = true; const bf16_t* x1; bf16_t* x2; float* ssq; const int* lists;
    __device__ __forceinline__ void operator()(const f32x4 (&acc)[2][2][4][2], const MUnit& u, int wr, int wc, int fr, int fq) const {
        const int* list = lists + (size_t)u.cat * T; const int col0 = u.pn * 256 + wc * 32 + 8 * fq;
#pragma unroll
        for (int ai = 0; ai < 2; ++ai)
#pragma unroll
            for (int m = 0; m < 4; ++m) { const int rl = ai * 128 + wr * 64 + m * 16 + fr, sl = u.slot0 + rl; const bool v = sl < u.n; const int tok = list[v ? sl : u.slot0];
                const size_t off = (size_t)tok * D + col0; float sq = 0.f;
#pragma unroll
                for (int bj = 0; bj < 2; ++bj) { f32x4 r0, r1; unpack8(*(const u32x4*)(x1 + off + bj * 128), r0, r1); r0 += acc[ai][bj][m][0]; r1 += acc[ai][bj][m][1];
                    sq += sq4(r0) + sq4(r1); if (v) *(u32x4*)(x2 + off + bj * 128) = pack8(r0, r1); }
                sq += __shfl_xor(sq, 16); sq += __shfl_xor(sq, 32); if (fq == 0 && v) atomicAdd(ssq + tok, sq); } } };
__device__ __forceinline__ void phase_moe2(const Ptrs& P, LAS unsigned char* lds) {
    PbMoe2 pb{(const char*)(P.ws + WS_HID), (const char*)(P.ws + WS_W2), (const unsigned*)(P.ws + WS_CTL), (int)gridDim.x, (int)blockIdx.x};
    EpiX2 ep{(const bf16_t*)(P.ws + WS_RB), (bf16_t*)(P.ws + WS_X2), (float*)(P.ws + WS_SSQ3), (const int*)(P.ws + WS_LIST)};
    pg8::gemm_phase<PbMoe2, EpiX2, true>(lds, pb, ep);
}
struct EpiPP { static constexpr bool PERM = true; bf16_t* pp;
    __device__ __forceinline__ void operator()(const f32x4 (&acc)[2][2][4][2], const pg8::DUnit& u, int wr, int wc, int fr, int fq) const {
        const int row0 = u.pm * 256 + wr * 64 + fr, col0 = u.pn * 256 + wc * 32 + 8 * fq;
#pragma unroll
        for (int ai = 0; ai < 2; ++ai)
#pragma unroll
            for (int m = 0; m < 4; ++m) { bf16_t* rp = pp + (size_t)(row0 + ai * 128 + m * 16) * D + col0;
#pragma unroll
                for (int bj = 0; bj < 2; ++bj) *(u32x4*)(rp + bj * 128) = pack8(acc[ai][bj][m][0], acc[ai][bj][m][1]); } } };
struct EpiPle { static constexpr bool PERM = true; const bf16_t* x2; const bf16_t* pp; const float* ssq3; bf16_t* x3; float* ssq4;
    __device__ __forceinline__ void operator()(const f32x4 (&acc)[2][2][4][2], const pg8::DUnit& u, int wr, int wc, int fr, int fq) const {
        const int row0 = u.pm * 256 + wr * 64 + fr, col0 = u.pn * 256 + wc * 32 + 8 * fq;
#pragma unroll
        for (int ai = 0; ai < 2; ++ai)
#pragma unroll
            for (int m = 0; m < 4; ++m) { const int row = row0 + ai * 128 + m * 16; const size_t off = (size_t)row * D + col0; float sq = 0.f;
                const float rstd = rsqrtf(__hip_atomic_load(ssq3 + row, __ATOMIC_RELAXED, __HIP_MEMORY_SCOPE_AGENT) * (1.f / D) + EPS);
#pragma unroll
                for (int bj = 0; bj < 2; ++bj) { f32x4 a0, a1, p0, p1; unpack8(*(const u32x4*)(x2 + off + bj * 128), a0, a1); unpack8(*(const u32x4*)(pp + off + bj * 128), p0, p1);
#pragma unroll
                    for (int j = 0; j < 4; ++j) { a0[j] += sigmoidf_(acc[ai][bj][m][0][j] * rstd) * p0[j]; a1[j] += sigmoidf_(acc[ai][bj][m][1][j] * rstd) * p1[j]; }
                    sq += sq4(a0) + sq4(a1); *(u32x4*)(x3 + off + bj * 128) = pack8(a0, a1); }
                ssq_add(ssq4, row, sq, fq); } } };
__device__ __forceinline__ void phase_final(const Ptrs& P, int tid) {
    const int lane = tid & 63, gw = blockIdx.x * 8 + (tid >> 6), ngw = gridDim.x * 8;
    const bf16_t* x3 = (const bf16_t*)(P.ws + WS_X3); const float* ssq4 = (const float*)(P.ws + WS_SSQ4);
    for (int m = gw; m < T; m += ngw) {
        const float rstd = rsqrtf(ssq4[m] * (1.f / D) + EPS);
        for (int c = lane; c < D; c += 64) P.out[(size_t)m * D + c] = bf2f(x3[(size_t)m * D + c]) * rstd * P.g_final[c];
    }
}

__global__ void __launch_bounds__(NTHREADS, 2) mega_fwd(Ptrs P) {
    extern __shared__ __attribute__((aligned(16))) unsigned char lds_raw[];
    LAS unsigned char* lds = (LAS unsigned char*)lds_raw;
    const int tid = threadIdx.x;
    LAS unsigned* lctl = (LAS unsigned*)(lds + LDSCTL_OFF);
    for (int u = tid; u < 64; u += NTHREADS) lctl[u] = 0u;
    __syncthreads();
    XcdBarrier bar = xcd_barrier_post((unsigned*)(P.ws + WS_CTL) + CW_BAR, (volatile LAS unsigned*)(lctl + 8));

    phase_prep(P, lds, tid);
    xcd_barrier(bar);
    { pg8::PbDense pb; pb.init(P.ws + WS_RB, D, P.ws + WS_WIN, D, T, NPROJ, D); EpiProj ep{(bf16_t*)(P.ws + WS_PROJ), (const float*)(P.ws + WS_RSTD1)};
      pg8::gemm_phase<pg8::PbDense, EpiProj, true>(lds, pb, ep); }
    phase_alow(P, tid);
    xcd_barrier(bar);
    phase_gla_a(P, lds, tid);
    xcd_barrier(bar);
    phase_gla_b(P, tid);
    xcd_barrier(bar);
    phase_gla_c(P, lds, tid);
    xcd_barrier(bar);
    { pg8::PbDense pb; pb.init(P.ws + WS_Y, D, P.ws + WS_WOUT, D, T, D, D); EpiOut ep{P.x, (bf16_t*)(P.ws + WS_RB), (float*)(P.ws + WS_SSQ2)};
      pg8::gemm_phase<pg8::PbDense, EpiOut, true>(lds, pb, ep); }
    xcd_barrier(bar);
    phase_route(P, tid);
    xcd_barrier(bar);
    phase_moe1(P, lds);
    { pg8::PbDense pb; pb.init(P.ws + WS_PB, DPLE, P.ws + WS_WPP, DPLE, T, D, DPLE); EpiPP ep{(bf16_t*)(P.ws + WS_Y)};
      pg8::gemm_phase<pg8::PbDense, EpiPP, true>(lds, pb, ep); }
    xcd_barrier(bar);
    phase_moe2(P, lds);
    xcd_barrier(bar);
    { pg8::PbDense pb; pb.init(P.ws + WS_X2, D, P.ws + WS_WPG, D, T, D, D);
      EpiPle ep{(const bf16_t*)(P.ws + WS_X2), (const bf16_t*)(P.ws + WS_Y), (const float*)(P.ws + WS_SSQ3), (bf16_t*)(P.ws + WS_X3), (float*)(P.ws + WS_SSQ4)};
      pg8::gemm_phase<pg8::PbDense, EpiPle, true>(lds, pb, ep); }
    xcd_barrier(bar);
    phase_final(P, tid);
}

extern "C" void kernel_launch(void* const* d_in, const int* in_sizes, int n_in, void* d_out, int out_size, void* d_ws, size_t ws_size, hipStream_t stream) {
    static int grid = 0;
    if (grid == 0) {
        if (n_in != 21 || in_sizes[0] != T * D || out_size != T * D || ws_size < WS_END) {
            fprintf(stderr, "kernel_launch: unexpected shapes: n_in %d in0 %d out %d ws %zu\n", n_in, n_in > 0 ? in_sizes[0] : -1, out_size, ws_size); grid = -1; return; }
        int dev = 0, cus = 0, per_cu = 0;
        if (hipGetDevice(&dev) != hipSuccess || hipDeviceGetAttribute(&cus, hipDeviceAttributeMultiprocessorCount, dev) != hipSuccess) { grid = -1; return; }
        if (hipFuncSetAttribute((const void*)mega_fwd, hipFuncAttributeMaxDynamicSharedMemorySize, LDS_BYTES) != hipSuccess) { fprintf(stderr, "kernel_launch: hipFuncSetAttribute failed\n"); grid = -1; return; }
        if (hipOccupancyMaxActiveBlocksPerMultiprocessor(&per_cu, (const void*)mega_fwd, NTHREADS, LDS_BYTES) != hipSuccess || per_cu < 1) {
            fprintf(stderr, "kernel_launch: occupancy query says %d workgroups per CU; not launching\n", per_cu); grid = -1; return; }
        (void)hipGetLastError();
        grid = cus;
    }
    if (grid < 0) return;
    Ptrs P{};
    const float** pp = (const float**)&P;
    for (int i = 0; i < 21; ++i) pp[i] = (const float*)d_in[i];
    P.out = (float*)d_out; P.ws = (unsigned char*)d_ws;
    if (hipMemsetAsync((char*)d_ws + WS_CTL, 0, CTL_BYTES, stream) != hipSuccess) { fprintf(stderr, "kernel_launch: memset failed\n"); return; }
    hipLaunchKernelGGL(mega_fwd, dim3(grid), dim3(NTHREADS), LDS_BYTES, stream, P);
}
```

```cpp
#include <hip/hip_runtime.h>
#include <cstdio>
#include <cstdint>

typedef unsigned short bf16_t;
typedef short bf16x8 __attribute__((ext_vector_type(8)));
typedef float f32x4 __attribute__((ext_vector_type(4)));
typedef unsigned u32x4 __attribute__((ext_vector_type(4)));
typedef unsigned u32x2 __attribute__((ext_vector_type(2)));
#define LAS __attribute__((address_space(3)))

constexpr int D = 1024, NB = 2, S = 8192, T = NB * S, DPLE = 256;
constexpr int H = 4, DK = 64, DV = 128, LR = 16, QK = 256, GV = 512, CW = 512;
constexpr int DIN = 3088, NPROJ = 3072;
constexpr int NE = 16, DE = 512, NCAT = 24;
constexpr float EPS = 1e-6f;
constexpr int PQ = 0, PK = 256, PV = 512, PG = 1024, PB = 1536, PC = 2048, PU = 2560;
constexpr int MAXRT = 88;
constexpr int NTHREADS = 512;

constexpr size_t MiB = 1u << 20;
constexpr size_t WS_CTL = 0, CTL_BYTES = 1 * MiB;
constexpr int CW_BAR = 4096;
constexpr size_t WS_SSQ2 = 256 * 1024;
constexpr size_t WS_SSQ3 = WS_SSQ2 + 64 * 1024;
constexpr size_t WS_SSQ4 = WS_SSQ3 + 64 * 1024;
constexpr size_t WS_WIN = 1 * MiB;
constexpr size_t WS_WOUT = 7 * MiB;
constexpr size_t WS_WPG = 9 * MiB;
constexpr size_t WS_WPP = 11 * MiB;
constexpr size_t WS_WA = 11 * MiB + 512 * 1024;
constexpr size_t WS_WR = 11 * MiB + 768 * 1024;
constexpr size_t WS_W1 = 12 * MiB;
constexpr size_t WS_W2 = 44 * MiB;
constexpr size_t WS_SMALL = 60 * MiB;
constexpr size_t WS_RSTD1 = WS_SMALL;
constexpr size_t WS_ALOW = WS_SMALL + 64 * 1024;
constexpr size_t WS_TOKI = WS_ALOW + 1 * MiB;
constexpr size_t WS_LIST = WS_TOKI + 256 * 1024;
constexpr size_t WS_DEC = 63 * MiB;
constexpr size_t WS_ST = 232 * MiB;
constexpr size_t WS_RB = 64 * MiB;
constexpr size_t WS_PB = 96 * MiB;
constexpr size_t WS_PROJ = 104 * MiB;
constexpr size_t WS_HID = WS_PROJ;
constexpr size_t WS_X2 = WS_PROJ + 44 * MiB;
constexpr size_t WS_Y = 200 * MiB;
constexpr size_t WS_X3 = WS_RB;
constexpr size_t WS_END = 256 * MiB;
static_assert(WS_LIST + (size_t)NCAT * T * 4 <= WS_RB, "small arrays fit");
static_assert(WS_Y + (size_t)T * D * 2 <= WS_END && WS_X2 + (size_t)T * D * 2 <= WS_Y, "map");

constexpr int LDS_BYTES = 147456;
constexpr int LDSCTL_OFF = 131072;

struct TokInfo { int cat; float w_lo, w_hi, rstd; };

__device__ __forceinline__ float bf2f(bf16_t v) { return __uint_as_float(((unsigned)v) << 16); }
__device__ __forceinline__ bf16_t f2bf(float f) { unsigned u = __float_as_uint(f); return (bf16_t)((u + 0x7fffu + ((u >> 16) & 1u)) >> 16); }
__device__ __forceinline__ unsigned pk2(float lo, float hi) { return (unsigned)f2bf(lo) | ((unsigned)f2bf(hi) << 16); }
__device__ __forceinline__ float wave_sum(float v) {
#pragma unroll
    for (int o = 1; o < 64; o <<= 1) v += __shfl_xor(v, o);
    return v;
}
__device__ __forceinline__ float sigmoidf_(float x) { return 1.0f / (1.0f + __expf(-x)); }
__device__ __forceinline__ float siluf_(float x) { return x * sigmoidf_(x); }
__device__ __forceinline__ float logsigmoidf_(float x) { return fminf(x, 0.f) - log1pf(__expf(-fabsf(x))); }

__device__ __forceinline__ unsigned cvt_pk_bf16(float lo, float hi) { unsigned r; asm volatile("v_cvt_pk_bf16_f32 %0, %1, %2" : "=v"(r) : "v"(lo), "v"(hi)); return r; }
__device__ __forceinline__ void ssq_add(float* ssq, int row, float s, int fq) { s += __shfl_xor(s, 16); s += __shfl_xor(s, 32); if (fq == 0) atomicAdd(ssq + row, s); }
__device__ __forceinline__ float sq4(const f32x4& v) { return (v[0] * v[0] + v[1] * v[1]) + (v[2] * v[2] + v[3] * v[3]); }
__device__ __forceinline__ u32x4 pack8(const f32x4& a, const f32x4& b) { u32x4 w; w.x = cvt_pk_bf16(a[0], a[1]); w.y = cvt_pk_bf16(a[2], a[3]); w.z = cvt_pk_bf16(b[0], b[1]); w.w = cvt_pk_bf16(b[2], b[3]); return w; }
__device__ __forceinline__ void unpack8(const u32x4& w, f32x4& a, f32x4& b) {
    a[0] = __uint_as_float(w.x << 16); a[1] = __uint_as_float(w.x & 0xffff0000u); a[2] = __uint_as_float(w.y << 16); a[3] = __uint_as_float(w.y & 0xffff0000u);
    b[0] = __uint_as_float(w.z << 16); b[1] = __uint_as_float(w.z & 0xffff0000u); b[2] = __uint_as_float(w.w << 16); b[3] = __uint_as_float(w.w & 0xffff0000u); }

struct Ptrs {
    const float *x, *p, *g_mix, *w_in, *w_gla_gate, *b_gla_gate, *g_gla_out, *w_conv, *w_out, *g_moe, *w_group, *b_group, *w_router, *b_router,
        *w_exp_gate, *w_exp_up, *w_exp_down, *g_ple, *w_ple_gate, *w_ple_proj, *g_final;
    float* out; unsigned char* ws;
};

#define XB_TMO      128
#define XB_XCNT(j)  (256  + 64 * (j))
#define XB_XSUB(j)  (1280 + 64 * (j))
#define XB_XGEN(j)  (2304 + 64 * (j))
#define XB_TOP      3328
#define XB_TOPGEN   3392
#define XCD_BAR_WORDS 3456
#define XB_SPIN_CAP (1u << 18)
__device__ __forceinline__ unsigned xb_ld(unsigned* p)              { return __hip_atomic_load(p, __ATOMIC_RELAXED, __HIP_MEMORY_SCOPE_AGENT); }
__device__ __forceinline__ unsigned xb_add(unsigned* p, unsigned v) { return __hip_atomic_fetch_add(p, v, __ATOMIC_RELAXED, __HIP_MEMORY_SCOPE_AGENT); }
__device__ __forceinline__ unsigned xb_xcc_id() { return (unsigned)__builtin_amdgcn_s_getreg((3 << 11) | 20) & 0xFu; }
#define XB_SPIN(cond, bar) do { unsigned _sp = 0; while (cond) { __builtin_amdgcn_s_sleep(1); \
    if ((++_sp & 255u) == 0u) { if (xb_ld(&(bar)[XB_TMO])) break; if (_sp > XB_SPIN_CAP) { atomicAdd(&(bar)[XB_TMO], 1u); break; } } } } while (0)
struct XcdBarrier { unsigned* bar; unsigned x; volatile LAS unsigned* st; };
__device__ __forceinline__ XcdBarrier xcd_barrier_post(unsigned* bar, volatile LAS unsigned* st) {
    XcdBarrier b; b.bar = bar; b.x = xb_xcc_id(); b.st = st;
    if (threadIdx.x == 0) (void)xb_add(&bar[XB_XCNT(b.x)], 1u);
    return b;
}
__device__ __forceinline__ void xcd_barrier_complete(unsigned* bar, unsigned x, unsigned& nloc, unsigned& nx) {
    const unsigned G = gridDim.x * gridDim.y * gridDim.z;
    unsigned sum, cnt, mine, sp = 0u;
    for (;;) {
        sum = 0u; cnt = 0u; mine = 0u;
#pragma unroll
        for (unsigned j = 0; j < 16; ++j) { const unsigned c = xb_ld(&bar[XB_XCNT(j)]); sum += c; cnt += (c > 0u) ? 1u : 0u; mine = (j == x) ? c : mine; }
        if (sum == G) break;
        __builtin_amdgcn_s_sleep(1);
        if ((++sp & 255u) == 0u) { if (xb_ld(&bar[XB_TMO])) break; if (sp > XB_SPIN_CAP) { atomicAdd(&bar[XB_TMO], 1u); break; } }
    }
    nloc = mine > 0u ? mine : 1u; nx = cnt > 0u ? cnt : 1u;
}
__device__ __forceinline__ void xcd_barrier(const XcdBarrier& b) {
    asm volatile("s_waitcnt vmcnt(0)" ::: "memory");
    __syncthreads();
    if (threadIdx.x == 0) {
        unsigned* bar = b.bar;
        __builtin_amdgcn_s_waitcnt(0);
        unsigned nloc = b.st[0], nx = b.st[1];
        if (nloc == 0u) { xcd_barrier_complete(bar, b.x, nloc, nx); b.st[0] = nloc; b.st[1] = nx; }
        const unsigned old = xb_add(&bar[XB_XSUB(b.x)], 1u);
        const unsigned gen = old / nloc;
        if (old + 1u == (gen + 1u) * nloc) {
            __builtin_amdgcn_fence(__ATOMIC_RELEASE, "agent");
            asm volatile("s_waitcnt vmcnt(0)" ::: "memory");
            const unsigned og = xb_add(&bar[XB_TOP], 1u);
            const unsigned tg = og / nx;
            if (og + 1u == (tg + 1u) * nx) xb_add(&bar[XB_TOPGEN], 1u);
            else XB_SPIN(xb_ld(&bar[XB_TOPGEN]) == tg, bar);
            __builtin_amdgcn_fence(__ATOMIC_ACQUIRE, "agent");
            xb_add(&bar[XB_XGEN(b.x)], 1u);
            asm volatile("s_waitcnt vmcnt(0)" ::: "memory");
        } else {
            XB_SPIN(xb_ld(&bar[XB_XGEN(b.x)]) == gen, bar);
            __builtin_amdgcn_fence(__ATOMIC_ACQUIRE, "agent");
            asm volatile("s_waitcnt vmcnt(0)" ::: "memory");
        }
    }
    __syncthreads();
}

__device__ __forceinline__ void transpose_item(const float* W, int ldw, const float* gain, bf16_t* WT, int ldt, int k0, int nsrc0, int rdst0, LAS float* scr, int lane) {
#pragma unroll 8
    for (int i = 0; i < 32; ++i) { const int kk = 2 * i + (lane >> 5); float v = W[(size_t)(k0 + kk) * ldw + nsrc0 + (lane & 31)]; if (gain) v *= gain[k0 + kk]; scr[kk * 33 + (lane & 31)] = v; }
    asm volatile("s_waitcnt lgkmcnt(0)" ::: "memory");
    const int c = lane & 7;
#pragma unroll
    for (int j = 0; j < 4; ++j) { const int n = (lane >> 3) + 8 * j; const LAS float* sp = scr + (8 * c) * 33 + n;
        u32x4 o; o.x = pk2(sp[0 * 33], sp[1 * 33]); o.y = pk2(sp[2 * 33], sp[3 * 33]); o.z = pk2(sp[4 * 33], sp[5 * 33]); o.w = pk2(sp[6 * 33], sp[7 * 33]);
        *(u32x4*)(WT + (size_t)(rdst0 + n) * ldt + k0 + 8 * c) = o; }
    asm volatile("s_waitcnt lgkmcnt(0)" ::: "memory");
}
constexpr int IT_WIN = (D / 64) * (NPROJ / 32), IT_SQ = (D / 64) * (D / 32), IT_WPP = (DPLE / 64) * (D / 32), IT_W1 = (D / 64) * (DE / 32), IT_W2 = (DE / 64) * (D / 32);
constexpr int ITB_WOUT = IT_WIN, ITB_WPG = ITB_WOUT + IT_SQ, ITB_WPP = ITB_WPG + IT_SQ, ITB_W1 = ITB_WPP + IT_WPP, ITB_W2 = ITB_W1 + 32 * IT_W1, IT_TOTAL = ITB_W2 + 16 * IT_W2;
__device__ __forceinline__ void phase_prep(const Ptrs& P, LAS unsigned char* lds, int tid) {
    const int lane = tid & 63, wid = tid >> 6, gw = blockIdx.x * 8 + wid, ngw = gridDim.x * 8;
    LAS float* s_wa = (LAS float*)lds;
    for (int k = tid; k < D; k += NTHREADS) { const float g = P.g_mix[k]; const f32x4* src = (const f32x4*)(P.w_in + (size_t)k * DIN + 1536);
#pragma unroll
        for (int q = 0; q < 4; ++q) { const f32x4 v = src[q] * g; s_wa[(4 * q + 0) * D + k] = v.x; s_wa[(4 * q + 1) * D + k] = v.y; s_wa[(4 * q + 2) * D + k] = v.z; s_wa[(4 * q + 3) * D + k] = v.w; } }
    __syncthreads();
    bf16_t* xb = (bf16_t*)(P.ws + WS_RB); float* rstd1 = (float*)(P.ws + WS_RSTD1); bf16_t* pb = (bf16_t*)(P.ws + WS_PB); float* alow = (float*)(P.ws + WS_ALOW);
    for (int m = gw; m < T; m += ngw) {
        const f32x4* xr = (const f32x4*)(P.x + (size_t)m * D) + lane; f32x4 v[4]; float ss = 0.f;
#pragma unroll
        for (int j = 0; j < 4; ++j) { v[j] = xr[64 * j]; ss += sq4(v[j]); }
        const f32x4 pv = ((const f32x4*)(P.p + (size_t)m * DPLE))[lane];
        ss = wave_sum(ss);
        const float rstd = rsqrtf(ss * (1.f / D) + EPS);
        float mine = 0.f;
#pragma unroll
        for (int jj = 0; jj < LR; ++jj) { float t = 0.f;
#pragma unroll
            for (int j = 0; j < 4; ++j) { const f32x4 w4 = *(const LAS f32x4*)(s_wa + jj * D + 256 * j + 4 * lane); t += (v[j].x * w4.x + v[j].y * w4.y) + (v[j].z * w4.z + v[j].w * w4.w); }
            t = wave_sum(t); if (lane == jj) mine = t;
            if ((jj & 3) == 3) asm volatile("" ::: "memory"); }
        if (lane < LR) alow[(size_t)m * LR + lane] = mine * rstd;
        if (lane == 0) rstd1[m] = rstd;
        u32x2* o = (u32x2*)(xb + (size_t)m * D) + lane;
#pragma unroll
        for (int j = 0; j < 4; ++j) { u32x2 w; w.x = pk2(v[j].x, v[j].y); w.y = pk2(v[j].z, v[j].w); o[64 * j] = w; }
        u32x2 w; w.x = pk2(pv.x, pv.y); w.y = pk2(pv.z, pv.w);
        ((u32x2*)(pb + (size_t)m * DPLE))[lane] = w;
    }
    __syncthreads();
    LAS float* scr = (LAS float*)lds + wid * (64 * 33);
    for (int it = gw; it < IT_TOTAL; it += ngw) {
        if (it < ITB_WOUT) { const int kb = it / (NPROJ / 32), nb = it % (NPROJ / 32), n0 = nb * 32; transpose_item(P.w_in, DIN, P.g_mix, (bf16_t*)(P.ws + WS_WIN), D, kb * 64, n0 < 1536 ? n0 : n0 + 16, n0, scr, lane); }
        else if (it < ITB_WPG) { const int r = it - ITB_WOUT; transpose_item(P.w_out, D, nullptr, (bf16_t*)(P.ws + WS_WOUT), D, (r / 32) * 64, (r % 32) * 32, (r % 32) * 32, scr, lane); }
        else if (it < ITB_WPP) { const int r = it - ITB_WPG; transpose_item(P.w_ple_gate, D, P.g_ple, (bf16_t*)(P.ws + WS_WPG), D, (r / 32) * 64, (r % 32) * 32, (r % 32) * 32, scr, lane); }
        else if (it < ITB_W1) { const int r = it - ITB_WPP; transpose_item(P.w_ple_proj, D, nullptr, (bf16_t*)(P.ws + WS_WPP), DPLE, (r / 32) * 64, (r % 32) * 32, (r % 32) * 32, scr, lane); }
        else if (it < ITB_W2) { const int q = it - ITB_W1, j = q / IT_W1, r = q % IT_W1, e = j >> 1, half = j & 1, n0 = (r % 16) * 32;
            transpose_item((half ? P.w_exp_up : P.w_exp_gate) + (size_t)e * D * DE, DE, P.g_moe, (bf16_t*)(P.ws + WS_W1) + (size_t)e * D * D, D, (r / 16) * 64, n0, ((n0 >> 7) << 8) + half * 128 + (n0 & 127), scr, lane); }
        else { const int q = it - ITB_W2, e = q / IT_W2, r = q % IT_W2, g = e >> 2, el = e & 3;
            transpose_item(P.w_exp_down + (size_t)e * DE * D, D, nullptr, (bf16_t*)(P.ws + WS_W2) + (size_t)g * D * 2048 + el * DE, 2048, (r / 32) * 64, (r % 32) * 32, (r % 32) * 32, scr, lane); }
    }
    bf16_t* WRh = (bf16_t*)(P.ws + WS_WR); bf16_t* WRl = WRh + 32 * D;
    for (int i = blockIdx.x * NTHREADS + tid; i < 32 * D; i += gridDim.x * NTHREADS) { const int j = i / D, k = i % D; float v = 0.f;
        if (j < 20) v = P.g_moe[k] * (j < 4 ? P.w_group[k * 4 + j] : P.w_router[k * NE + (j - 4)]);
        const bf16_t hi = f2bf(v); WRh[i] = hi; WRl[i] = f2bf(v - bf2f(hi)); }
}

namespace pg8 {
constexpr int BM = 256, BK = 64, HALF = 128, HTB = HALF * BK * 2, STAGE_BYTES = 8 * HTB, NXCD = 8, WGM = 8;
__device__ __forceinline__ int lds_byte(int r, int c) { const int st = (r >> 4) * 2 + (c >> 5), rr = r & 15, cc = c & 31, ob = rr * 64 + cc * 2; return st * 1024 + (ob ^ (((ob >> 9) & 1) << 5)); }
__device__ __forceinline__ void stage_rc(int b, int& R, int& C) { const int st = b / 1024, sb = b % 1024, swz = sb ^ (((sb >> 9) & 1) << 5); R = (st >> 1) * 16 + swz / 64; C = (st & 1) * 32 + (swz % 64) / 2; }
__device__ __forceinline__ int perm32(int rho) { const int n = rho >> 4, i = rho & 15; return 8 * (i >> 2) + 4 * n + (i & 3); }

struct StaticOrder {
    int nM, nN, nwg, G, c;
    __device__ void init(int M, int N, int G_, int c_) { nM = M / BM; nN = N / BM; nwg = nM * nN; G = G_; c = c_; }
    __device__ bool next(int i, int& pm, int& pn) const {
        const long L = (long)i * G + c; if (L >= nwg) return false;
        int wgid = (int)L; { const int q = nwg / NXCD, r = nwg % NXCD, xcd = wgid % NXCD, off = wgid / NXCD; wgid = (xcd < r ? xcd * (q + 1) : r * (q + 1) + (xcd - r) * q) + off; }
        const int nig = WGM * nN, gid = wgid / nig, fm = gid * WGM, gsz = (nM - fm) < WGM ? (nM - fm) : WGM;
        pm = fm + ((wgid % nig) % gsz); pn = (wgid % nig) / gsz; return true;
    }
};

template <class Pb, class Epi, bool ALIGN_EPI>
__device__ __forceinline__ void gemm_phase(LAS unsigned char* lds, const Pb& S, const Epi& E) {
    const int tid = threadIdx.x, wid = __builtin_amdgcn_readfirstlane(tid >> 6), lane = tid & 63, wr = wid >> 2, wc = wid & 3, fr = lane & 15, fq = lane >> 4;
    const int nt = S.nt();
    int R[2], C[2]; unsigned voffB[2];
#pragma unroll
    for (int i = 0; i < 2; ++i) { stage_rc(tid * 16 + i * 8192, R[i], C[i]); const int Rb = Epi::PERM ? ((R[i] & ~31) + perm32(R[i] & 31)) : R[i]; voffB[i] = (unsigned)(Rb * (int)S.ldb() + C[i]) * 2u; }
    const size_t hstepB = (size_t)HALF * S.ldb() * 2;
    const unsigned ldsw = (unsigned)wid * 1024u;
    const int aoff = lds_byte(wr * 64 + fr, fq * 8), boff = lds_byte(wc * 32 + fr, fq * 8);
    const char* const abase = S.a_base();
#define PG8_SA(b, h) (((b) * 2 + (h)) * HTB)
#define PG8_SB(b, h) ((4 + (b) * 2 + (h)) * HTB)
#define PG8_STAGE_B(bufoff, gbase) do { _Pragma("unroll") for (int _i = 0; _i < 2; ++_i) \
        __builtin_amdgcn_global_load_lds((const unsigned*)((const char*)(gbase) + voffB[_i]), (LAS unsigned*)(lds + (bufoff) + ldsw + _i * 8192), 16, 0, 0); } while (0)
#define PG8_STAGE_A(bufoff, kbase, o0, o1) do { \
        __builtin_amdgcn_global_load_lds((const unsigned*)((kbase) + (o0)), (LAS unsigned*)(lds + (bufoff) + ldsw), 16, 0, 0); \
        __builtin_amdgcn_global_load_lds((const unsigned*)((kbase) + (o1)), (LAS unsigned*)(lds + (bufoff) + ldsw + 8192), 16, 0, 0); } while (0)
#define PG8_LDA(dst, b, h) do { _Pragma("unroll") for (int m = 0; m < 4; ++m) _Pragma("unroll") for (int k = 0; k < 2; ++k) dst[m][k] = *(const LAS bf16x8*)(lds + PG8_SA(b, h) + aoff + m * 2048 + k * 1024); } while (0)
#define PG8_LDB(dst, b, h) do { _Pragma("unroll") for (int n = 0; n < 2; ++n) _Pragma("unroll") for (int k = 0; k < 2; ++k) dst[n][k] = *(const LAS bf16x8*)(lds + PG8_SB(b, h) + boff + n * 2048 + k * 1024); } while (0)
#define PG8_MMA(ai, bj, At, Bt) do { __builtin_amdgcn_s_setprio(1); _Pragma("unroll") for (int m = 0; m < 4; ++m) _Pragma("unroll") for (int n = 0; n < 2; ++n) _Pragma("unroll") for (int k = 0; k < 2; ++k) \
        acc[ai][bj][m][n] = __builtin_amdgcn_mfma_f32_16x16x32_bf16(Bt[n][k], At[m][k], acc[ai][bj][m][n], 0, 0, 0); __builtin_amdgcn_s_setprio(0); } while (0)
#define PG8_WAIT_V(n) asm volatile("s_waitcnt vmcnt(" #n ")" ::: "memory")
#define PG8_WAIT_L(n) asm volatile("s_waitcnt lgkmcnt(" #n ")" ::: "memory")
#define PG8_BAR __builtin_amdgcn_s_barrier()
#define PG8_SCHED __builtin_amdgcn_sched_barrier(0)
    typename Pb::Unit cur, nxt; int ui = 0;
    if (!S.next(0, cur)) return;
    f32x4 acc[2][2][4][2];
#pragma unroll
    for (int a = 0; a < 2; ++a)
#pragma unroll
        for (int b = 0; b < 2; ++b)
#pragma unroll
            for (int m = 0; m < 4; ++m)
#pragma unroll
                for (int n = 0; n < 2; ++n) acc[a][b][m][n] = (f32x4){0.f, 0.f, 0.f, 0.f};
    bf16x8 At[4][2], B0[2][2], B1[2][2];
    unsigned aoc[2][2], aon[2][2];
    S.a_offs(cur, R, C, aoc);
    { const char* b0 = S.b_ptr(cur, 0); const char* b1 = S.b_ptr(cur, 1);
      PG8_STAGE_B(PG8_SB(0, 0), b0); PG8_STAGE_B(PG8_SB(0, 1), b0 + hstepB); PG8_STAGE_A(PG8_SA(0, 0), abase, aoc[0][0], aoc[0][1]); PG8_STAGE_A(PG8_SA(0, 1), abase, aoc[1][0], aoc[1][1]);
      if (wr == 1) PG8_BAR;
      PG8_WAIT_V(2); PG8_BAR;
      PG8_STAGE_B(PG8_SB(1, 0), b1); PG8_STAGE_A(PG8_SA(1, 0), abase + 128, aoc[0][0], aoc[0][1]); PG8_STAGE_B(PG8_SB(1, 1), b1 + hstepB);
      PG8_WAIT_V(6); PG8_BAR; }
    for (;;) {
        const bool has_next = S.next(ui + 1, nxt);
        if (has_next) S.a_offs(nxt, R, C, aon); else { nxt = cur; aon[0][0] = aoc[0][0]; aon[0][1] = aoc[0][1]; aon[1][0] = aoc[1][0]; aon[1][1] = aoc[1][1]; }
        for (int t = 0; t < nt; t += 2) {
            const bool last = (t == nt - 2);
            const char* ak1 = abase + (size_t)(t + 1) * 128;
            const char* ak2 = last ? abase : abase + (size_t)(t + 2) * 128;
            const char* ak3 = ak2 + 128;
            const char* b2 = last ? S.b_ptr(nxt, 0) : S.b_ptr(cur, t + 2); const char* b3 = last ? S.b_ptr(nxt, 1) : S.b_ptr(cur, t + 3);
            const unsigned o00 = last ? aon[0][0] : aoc[0][0], o01 = last ? aon[0][1] : aoc[0][1], o10 = last ? aon[1][0] : aoc[1][0], o11 = last ? aon[1][1] : aoc[1][1];
            PG8_LDB(B0, 0, 0); PG8_LDB(B1, 0, 1); PG8_SCHED; PG8_LDA(At, 0, 0); PG8_STAGE_A(PG8_SA(1, 1), ak1, aoc[1][0], aoc[1][1]);
            PG8_WAIT_V(8); PG8_WAIT_L(0); PG8_BAR; PG8_MMA(0, 0, At, B0); PG8_MMA(0, 1, At, B1); PG8_BAR; PG8_SCHED;
            PG8_LDA(At, 0, 1); PG8_STAGE_B(PG8_SB(0, 0), b2); PG8_STAGE_B(PG8_SB(0, 1), b2 + hstepB); PG8_STAGE_A(PG8_SA(0, 0), ak2, o00, o01);
            PG8_WAIT_V(8); PG8_WAIT_L(0); PG8_BAR; PG8_MMA(1, 0, At, B0); PG8_MMA(1, 1, At, B1); PG8_BAR; PG8_SCHED;
            PG8_LDB(B0, 1, 0); PG8_LDB(B1, 1, 1); PG8_SCHED; PG8_LDA(At, 1, 0); PG8_STAGE_A(PG8_SA(0, 1), ak2, o10, o11);
            PG8_WAIT_V(8); PG8_WAIT_L(0); PG8_BAR; PG8_MMA(0, 0, At, B0); PG8_MMA(0, 1, At, B1); PG8_BAR; PG8_SCHED;
            PG8_LDA(At, 1, 1); PG8_STAGE_B(PG8_SB(1, 0), b3); PG8_STAGE_B(PG8_SB(1, 1), b3 + hstepB); PG8_STAGE_A(PG8_SA(1, 0), ak3, o00, o01);
            PG8_WAIT_V(8); PG8_WAIT_L(0); PG8_BAR; PG8_MMA(1, 0, At, B0); PG8_MMA(1, 1, At, B1); PG8_BAR; PG8_SCHED;
        }
        if constexpr (ALIGN_EPI) { if (wr == 0) PG8_BAR; }
        E(acc, cur, wr, wc, fr, fq);
        if (!has_next) break;
#pragma unroll
        for (int a = 0; a < 2; ++a)
#pragma unroll
            for (int b = 0; b < 2; ++b)
#pragma unroll
                for (int m = 0; m < 4; ++m)
#pragma unroll
                    for (int n = 0; n < 2; ++n) acc[a][b][m][n] = (f32x4){0.f, 0.f, 0.f, 0.f};
        cur = nxt; aoc[0][0] = aon[0][0]; aoc[0][1] = aon[0][1]; aoc[1][0] = aon[1][0]; aoc[1][1] = aon[1][1]; ++ui;
        if constexpr (ALIGN_EPI) { if (wr == 1) PG8_BAR; }
    }
    PG8_WAIT_V(0);
    if constexpr (!ALIGN_EPI) { if (wr == 0) PG8_BAR; }
    PG8_BAR;
#undef PG8_SA
#undef PG8_SB
#undef PG8_STAGE_A
#undef PG8_STAGE_B
#undef PG8_LDA
#undef PG8_LDB
#undef PG8_MMA
#undef PG8_WAIT_V
#undef PG8_WAIT_L
#undef PG8_BAR
#undef PG8_SCHED
}

struct DUnit { int pm, pn; };
struct PbDense {
    typedef DUnit Unit;
    const char* A; const char* Bt; int lda, ldb_, K; StaticOrder so;
    __device__ void init(const void* A_, int lda_, const void* Bt_, int ldb__, int M, int N, int K_) { A = (const char*)A_; Bt = (const char*)Bt_; lda = lda_; ldb_ = ldb__; K = K_; so.init(M, N, gridDim.x, blockIdx.x); }
    __device__ __forceinline__ bool next(int i, Unit& u) const { return so.next(i, u.pm, u.pn); }
    __device__ __forceinline__ int nt() const { return K / BK; }
    __device__ __forceinline__ const char* a_base() const { return A; }
    __device__ __forceinline__ unsigned ldb() const { return (unsigned)ldb_; }
    __device__ __forceinline__ void a_offs(const Unit& u, const int (&R)[2], const int (&C)[2], unsigned (&o)[2][2]) const {
#pragma unroll
        for (int h = 0; h < 2; ++h)
#pragma unroll
            for (int i = 0; i < 2; ++i) o[h][i] = (unsigned)((u.pm * BM + h * HALF + R[i]) * lda + C[i]) * 2u; }
    __device__ __forceinline__ const char* b_ptr(const Unit& u, int t) const { return Bt + (size_t)u.pn * BM * ldb_ * 2 + (size_t)t * 128; }
};
}

struct EpiProj { static constexpr bool PERM = true; bf16_t* proj; const float* rstd;
    __device__ __forceinline__ void operator()(const f32x4 (&acc)[2][2][4][2], const pg8::DUnit& u, int wr, int wc, int fr, int fq) const {
        const int row0 = u.pm * 256 + wr * 64 + fr, col0 = u.pn * 256 + wc * 32 + 8 * fq; const float sc = (u.pn == 0) ? 0.125f : 1.0f;
        float sv[2][4];
#pragma unroll
        for (int ai = 0; ai < 2; ++ai)
#pragma unroll
            for (int m = 0; m < 4; ++m) sv[ai][m] = rstd[row0 + ai * 128 + m * 16];
#pragma unroll
        for (int ai = 0; ai < 2; ++ai)
#pragma unroll
            for (int m = 0; m < 4; ++m) { const int row = row0 + ai * 128 + m * 16; const float s = sv[ai][m] * sc; bf16_t* rp = proj + (size_t)row * NPROJ + col0;
#pragma unroll
                for (int bj = 0; bj < 2; ++bj) *(u32x4*)(rp + bj * 128) = pack8(acc[ai][bj][m][0] * s, acc[ai][bj][m][1] * s); } } };
constexpr int LROW = 72;
__device__ __forceinline__ void phase_gla_a(const Ptrs& P, LAS unsigned char* lds, int tid) {
    const int lane = tid & 63, wid = tid >> 6, fr = lane & 15, fq = lane >> 4, d = lane, tg = wid;
    LAS float* s_alow = (LAS float*)lds;
    LAS float* s_tot = (LAS float*)(lds + 4096);
    LAS bf16_t* s_kd = (LAS bf16_t*)(lds + 8192);
    LAS bf16_t* s_vt = (LAS bf16_t*)(lds + 8192 + 64 * LROW * 2);
    bf16_t* proj = (bf16_t*)(P.ws + WS_PROJ); const float* alow = (const float*)(P.ws + WS_ALOW); float* sloc = (float*)(P.ws + WS_RB); float* dec = (float*)(P.ws + WS_DEC);
    for (int item = blockIdx.x; item < NB * H * (S / 64); item += gridDim.x) {
        const int bh = item >> 7, c = item & 127, b = bh >> 2, h = bh & 3; const size_t tok0 = (size_t)b * S + (size_t)c * 64;
        float wg[LR];
#pragma unroll
        for (int r = 0; r < LR; ++r) wg[r] = P.w_gla_gate[r * QK + h * DK + d];
        const float bg = P.b_gla_gate[h * DK + d];
        for (int i = tid; i < 64 * LR; i += NTHREADS) s_alow[i] = alow[tok0 * LR + i];
        float kv[8], qv[8];
#pragma unroll
        for (int j = 0; j < 8; ++j) { const size_t m = tok0 + tg * 8 + j; kv[j] = bf2f(proj[m * NPROJ + PK + h * DK + d]); qv[j] = bf2f(proj[m * NPROJ + PQ + h * DK + d]); }
        u32x4 vv[2];
#pragma unroll
        for (int i = 0; i < 2; ++i) { const int id = tid + i * NTHREADS; vv[i] = *(const u32x4*)(proj + (tok0 + (id >> 4)) * NPROJ + PV + h * DV + (id & 15) * 8); }
        __syncthreads();
        float cum[8]; float run = 0.f;
#pragma unroll
        for (int j = 0; j < 8; ++j) { const int t = tg * 8 + j; float z = bg;
#pragma unroll
            for (int r = 0; r < LR; ++r) z += s_alow[t * LR + r] * wg[r];
            run += logsigmoidf_(z) * (1.f / 16.f); cum[j] = run; }
        s_tot[tg * 64 + d] = run;
        __syncthreads();
        float pre = 0.f, last = 0.f;
#pragma unroll
        for (int g = 0; g < 8; ++g) { const float v = s_tot[g * 64 + d]; last += v; if (g < tg) pre += v; }
#pragma unroll
        for (int j = 0; j < 8; ++j) { const int t = tg * 8 + j; const size_t m = tok0 + t; const float cm = cum[j] + pre;
            proj[m * NPROJ + PQ + h * DK + d] = f2bf(qv[j] * __expf(cm)); proj[m * NPROJ + PK + h * DK + d] = f2bf(kv[j] * __expf(-cm));
            s_kd[d * LROW + t] = f2bf(kv[j] * __expf(last - cm)); }
#pragma unroll
        for (int i = 0; i < 2; ++i) { const int id = tid + i * NTHREADS, t = id >> 4, e0 = (id & 15) * 8;
            s_vt[(e0 + 0) * LROW + t] = (bf16_t)(vv[i].x & 0xffffu); s_vt[(e0 + 1) * LROW + t] = (bf16_t)(vv[i].x >> 16);
            s_vt[(e0 + 2) * LROW + t] = (bf16_t)(vv[i].y & 0xffffu); s_vt[(e0 + 3) * LROW + t] = (bf16_t)(vv[i].y >> 16);
            s_vt[(e0 + 4) * LROW + t] = (bf16_t)(vv[i].z & 0xffffu); s_vt[(e0 + 5) * LROW + t] = (bf16_t)(vv[i].z >> 16);
            s_vt[(e0 + 6) * LROW + t] = (bf16_t)(vv[i].w & 0xffffu); s_vt[(e0 + 7) * LROW + t] = (bf16_t)(vv[i].w >> 16); }
        if (tg == 0) dec[(size_t)item * DK + d] = __expf(last);
        __syncthreads();
#pragma unroll
        for (int dt = 0; dt < 4; ++dt) { f32x4 acc = (f32x4){0.f, 0.f, 0.f, 0.f};
#pragma unroll
            for (int kk = 0; kk < 2; ++kk) { const bf16x8 a = *(const LAS bf16x8*)(s_kd + (dt * 16 + fr) * LROW + kk * 32 + fq * 8), bq = *(const LAS bf16x8*)(s_vt + (wid * 16 + fr) * LROW + kk * 32 + fq * 8);
                acc = __builtin_amdgcn_mfma_f32_16x16x32_bf16(a, bq, acc, 0, 0, 0); }
            *(f32x4*)(sloc + (size_t)item * (DK * DV) + (size_t)(wid * 16 + fr) * DK + dt * 16 + 4 * fq) = acc; }
        __syncthreads();
    }
}
__device__ __forceinline__ void phase_gla_b(const Ptrs& P, int tid) {
    const int nb_scan = gridDim.x / 2;
    if ((int)blockIdx.x < nb_scan) {
        const float* sloc = (const float*)(P.ws + WS_RB); const float* dec = (const float*)(P.ws + WS_DEC); bf16_t* st = (bf16_t*)(P.ws + WS_ST);
        for (int gt = blockIdx.x * NTHREADS + tid; gt < NB * H * DK * DV; gt += nb_scan * NTHREADS) {
            const int bh = gt >> 13, idx = gt & 8191, d = idx & 63; float sv = 0.f;
#pragma unroll 8
            for (int c = 0; c < S / 64; ++c) { const size_t item = (size_t)bh * (S / 64) + c;
                st[item * (DK * DV) + idx] = f2bf(sv); sv = dec[item * DK + d] * sv + sloc[item * (DK * DV) + idx]; }
        }
    } else {
        const bf16_t* proj = (const bf16_t*)(P.ws + WS_PROJ); bf16_t* y = (bf16_t*)(P.ws + WS_Y);
        const int nth = (gridDim.x - nb_scan) * NTHREADS;
        for (int id = (blockIdx.x - nb_scan) * NTHREADS + tid; id < T * (CW / 8); id += nth) {
            const int tok = id >> 6, c0 = (id & 63) * 8, t = tok & (S - 1);
            f32x4 a0 = (f32x4){0.f, 0.f, 0.f, 0.f}, a1 = a0;
#pragma unroll
            for (int j = 0; j < 3; ++j) { if (t - 2 + j >= 0) { const size_t mm = (size_t)tok - 2 + j; f32x4 c_0, c_1, u_0, u_1;
                unpack8(*(const u32x4*)(proj + mm * NPROJ + PC + c0), c_0, c_1); unpack8(*(const u32x4*)(proj + mm * NPROJ + PU + c0), u_0, u_1);
                const f32x4 w0 = *(const f32x4*)(P.w_conv + j * CW + c0), w1 = *(const f32x4*)(P.w_conv + j * CW + c0 + 4);
                a0 += w0 * (c_0 * u_0); a1 += w1 * (c_1 * u_1); } }
            f32x4 b0, b1; unpack8(*(const u32x4*)(proj + (size_t)tok * NPROJ + PB + c0), b0, b1);
            *(u32x4*)(y + (size_t)tok * D + GV + c0) = pack8(b0 * a0, b1 * a1);
        }
    }
}
__device__ __forceinline__ void phase_gla_c(const Ptrs& P, LAS unsigned char* lds, int tid) {
    const int lane = tid & 63, wid = tid >> 6, fr = lane & 15, fq = lane >> 4;
    LAS bf16_t* s_q = (LAS bf16_t*)lds;
    LAS bf16_t* s_k = (LAS bf16_t*)(lds + 9216);
    LAS bf16_t* s_vt = (LAS bf16_t*)(lds + 18432);
    LAS bf16_t* s_st = (LAS bf16_t*)(lds + 36864);
    LAS bf16_t* s_p = (LAS bf16_t*)(lds + 55296);
    LAS float* s_red = (LAS float*)(lds + 64512);
    const bf16_t* proj = (const bf16_t*)(P.ws + WS_PROJ); const bf16_t* st = (const bf16_t*)(P.ws + WS_ST); bf16_t* y = (bf16_t*)(P.ws + WS_Y);
    const int tt = wid >> 1, wh = wid & 1;
    for (int item = blockIdx.x; item < NB * H * (S / 64); item += gridDim.x) {
        const int bh = item >> 7, c = item & 127, b = bh >> 2, h = bh & 3; const size_t tok0 = (size_t)b * S + (size_t)c * 64;
        { const int row = tid >> 3, ch = tid & 7;
          *(LAS u32x4*)(s_q + row * LROW + ch * 8) = *(const u32x4*)(proj + (tok0 + row) * NPROJ + PQ + h * DK + ch * 8);
          *(LAS u32x4*)(s_k + row * LROW + ch * 8) = *(const u32x4*)(proj + (tok0 + row) * NPROJ + PK + h * DK + ch * 8); }
#pragma unroll
        for (int i = 0; i < 2; ++i) { const int id = tid + i * NTHREADS, row = id >> 3, ch = id & 7;
            *(LAS u32x4*)(s_st + row * LROW + ch * 8) = *(const u32x4*)(st + (size_t)item * (DK * DV) + row * DK + ch * 8); }
#pragma unroll
        for (int i = 0; i < 2; ++i) { const int id = tid + i * NTHREADS, t = id >> 4, e0 = (id & 15) * 8;
            const u32x4 vv = *(const u32x4*)(proj + (tok0 + t) * NPROJ + PV + h * DV + e0);
            s_vt[(e0 + 0) * LROW + t] = (bf16_t)(vv.x & 0xffffu); s_vt[(e0 + 1) * LROW + t] = (bf16_t)(vv.x >> 16);
            s_vt[(e0 + 2) * LROW + t] = (bf16_t)(vv.y & 0xffffu); s_vt[(e0 + 3) * LROW + t] = (bf16_t)(vv.y >> 16);
            s_vt[(e0 + 4) * LROW + t] = (bf16_t)(vv.z & 0xffffu); s_vt[(e0 + 5) * LROW + t] = (bf16_t)(vv.z >> 16);
            s_vt[(e0 + 6) * LROW + t] = (bf16_t)(vv.w & 0xffffu); s_vt[(e0 + 7) * LROW + t] = (bf16_t)(vv.w >> 16); }
        __syncthreads();
#pragma unroll
        for (int si = 0; si < 2; ++si) { const int stile = wh * 2 + si; f32x4 acc = (f32x4){0.f, 0.f, 0.f, 0.f};
#pragma unroll
            for (int kk = 0; kk < 2; ++kk) { const bf16x8 a = *(const LAS bf16x8*)(s_k + (stile * 16 + fr) * LROW + kk * 32 + fq * 8), bq = *(const LAS bf16x8*)(s_q + (tt * 16 + fr) * LROW + kk * 32 + fq * 8);
                acc = __builtin_amdgcn_mfma_f32_16x16x32_bf16(a, bq, acc, 0, 0, 0); }
            const int t = tt * 16 + fr, s0 = stile * 16 + 4 * fq;
            u32x2 w; w.x = pk2(s0 + 0 <= t ? acc[0] : 0.f, s0 + 1 <= t ? acc[1] : 0.f); w.y = pk2(s0 + 2 <= t ? acc[2] : 0.f, s0 + 3 <= t ? acc[3] : 0.f);
            *(LAS u32x2*)(s_p + t * LROW + s0) = w; }
        __syncthreads();
        f32x4 o[4]; float sq = 0.f;
#pragma unroll
        for (int ei = 0; ei < 4; ++ei) { const int et = wh * 4 + ei; f32x4 acc = (f32x4){0.f, 0.f, 0.f, 0.f};
#pragma unroll
            for (int kk = 0; kk < 2; ++kk) { const bf16x8 a = *(const LAS bf16x8*)(s_st + (et * 16 + fr) * LROW + kk * 32 + fq * 8), bq = *(const LAS bf16x8*)(s_q + (tt * 16 + fr) * LROW + kk * 32 + fq * 8);
                acc = __builtin_amdgcn_mfma_f32_16x16x32_bf16(a, bq, acc, 0, 0, 0); }
#pragma unroll
            for (int kk = 0; kk < 2; ++kk) { const bf16x8 a = *(const LAS bf16x8*)(s_vt + (et * 16 + fr) * LROW + kk * 32 + fq * 8), bq = *(const LAS bf16x8*)(s_p + (tt * 16 + fr) * LROW + kk * 32 + fq * 8);
                acc = __builtin_amdgcn_mfma_f32_16x16x32_bf16(a, bq, acc, 0, 0, 0); }
            o[ei] = acc; sq += sq4(acc); }
        sq += __shfl_xor(sq, 16); sq += __shfl_xor(sq, 32);
        const int t = tt * 16 + fr;
        if (fq == 0) s_red[t * 2 + wh] = sq;
        __syncthreads();
        const float rstd = rsqrtf((s_red[t * 2] + s_red[t * 2 + 1]) * (1.f / DV) + EPS);
#pragma unroll
        for (int ei = 0; ei < 4; ++ei) { const int e0 = (wh * 4 + ei) * 16 + 4 * fq;
            const u32x2 gw = *(const u32x2*)(proj + (tok0 + t) * NPROJ + PG + h * DV + e0); const f32x4 gg = *(const f32x4*)(P.g_gla_out + e0);
            const float g0 = __uint_as_float(gw.x << 16), g1 = __uint_as_float(gw.x & 0xffff0000u), g2 = __uint_as_float(gw.y << 16), g3 = __uint_as_float(gw.y & 0xffff0000u);
            u32x2 w; w.x = pk2(o[ei][0] * rstd * gg[0] * siluf_(g0), o[ei][1] * rstd * gg[1] * siluf_(g1)); w.y = pk2(o[ei][2] * rstd * gg[2] * siluf_(g2), o[ei][3] * rstd * gg[3] * siluf_(g3));
            *(u32x2*)(y + (tok0 + t) * D + h * DV + e0) = w; }
        __syncthreads();
    }
}
struct EpiOut { static constexpr bool PERM = true; const float* x; bf16_t* x1; float* ssq;
    __device__ __forceinline__ void operator()(const f32x4 (&acc)[2][2][4][2], const pg8::DUnit& u, int wr, int wc, int fr, int fq) const {
        const int row0 = u.pm * 256 + wr * 64 + fr, col0 = u.pn * 256 + wc * 32 + 8 * fq;
#pragma unroll
        for (int ai = 0; ai < 2; ++ai)
#pragma unroll
            for (int m = 0; m < 4; ++m) { const int row = row0 + ai * 128 + m * 16; const size_t off = (size_t)row * D + col0; float sq = 0.f;
#pragma unroll
                for (int bj = 0; bj < 2; ++bj) { const f32x4 r0 = *(const f32x4*)(x + off + bj * 128) + acc[ai][bj][m][0], r1 = *(const f32x4*)(x + off + bj * 128 + 4) + acc[ai][bj][m][1];
                    sq += sq4(r0) + sq4(r1); *(u32x4*)(x1 + off + bj * 128) = pack8(r0, r1); }
                ssq_add(ssq, row, sq, fq); } } };
__device__ __forceinline__ void phase_route(const Ptrs& P, LAS unsigned char* lds, int tid) {
    const int lane = tid & 63, wid = tid >> 6, fr = lane & 15, fq = lane >> 4, gw = blockIdx.x * 8 + wid, ngw = gridDim.x * 8;
    const bf16_t* x1 = (const bf16_t*)(P.ws + WS_RB); const bf16_t* WRh = (const bf16_t*)(P.ws + WS_WR); const bf16_t* WRl = WRh + 32 * D; const float* ssq2 = (const float*)(P.ws + WS_SSQ2);
    TokInfo* ti = (TokInfo*)(P.ws + WS_TOKI); int* lists = (int*)(P.ws + WS_LIST); unsigned* cnt = (unsigned*)(P.ws + WS_CTL);
    LAS float* s_lg = (LAS float*)lds + wid * (16 * 33);
    for (int tile = gw; tile < T / 16; tile += ngw) {
        const int tok0 = tile * 16;
        f32x4 acc0 = (f32x4){0.f, 0.f, 0.f, 0.f}, acc1 = acc0;
#pragma unroll 4
        for (int ks = 0; ks < D / 32; ++ks) { const int ko = ks * 32 + fq * 8;
            const bf16x8 a = *(const bf16x8*)(x1 + (size_t)(tok0 + fr) * D + ko);
            const bf16x8 h0 = *(const bf16x8*)(WRh + fr * D + ko), h1 = *(const bf16x8*)(WRh + (16 + fr) * D + ko), l0 = *(const bf16x8*)(WRl + fr * D + ko), l1 = *(const bf16x8*)(WRl + (16 + fr) * D + ko);
            acc0 = __builtin_amdgcn_mfma_f32_16x16x32_bf16(a, h0, acc0, 0, 0, 0); acc0 = __builtin_amdgcn_mfma_f32_16x16x32_bf16(a, l0, acc0, 0, 0, 0);
            acc1 = __builtin_amdgcn_mfma_f32_16x16x32_bf16(a, h1, acc1, 0, 0, 0); acc1 = __builtin_amdgcn_mfma_f32_16x16x32_bf16(a, l1, acc1, 0, 0, 0); }
#pragma unroll
        for (int r = 0; r < 4; ++r) { s_lg[(4 * fq + r) * 33 + fr] = acc0[r]; s_lg[(4 * fq + r) * 33 + 16 + fr] = acc1[r]; }
        asm volatile("s_waitcnt lgkmcnt(0)" ::: "memory");
        if (lane < 16) {
            const int m = tok0 + lane; const LAS float* lg = s_lg + lane * 33;
            const float rstd = rsqrtf(__hip_atomic_load(ssq2 + m, __ATOMIC_RELAXED, __HIP_MEMORY_SCOPE_AGENT) * (1.f / D) + EPS);
            float gl[4]; int gs = 0;
#pragma unroll
            for (int j = 0; j < 4; ++j) gl[j] = lg[j] * rstd + P.b_group[j];
            float gbest = gl[0];
#pragma unroll
            for (int j = 1; j < 4; ++j) if (gl[j] > gbest) { gbest = gl[j]; gs = j; }
            float den = 0.f;
#pragma unroll
            for (int j = 0; j < 4; ++j) den += __expf(gl[j] - gbest);
            const float pgrp = 1.f / den;
            float el[4];
#pragma unroll
            for (int j = 0; j < 4; ++j) el[j] = lg[4 + gs * 4 + j] * rstd + P.b_router[gs * 4 + j];
            int i0 = 0; float v0 = el[0];
#pragma unroll
            for (int j = 1; j < 4; ++j) if (el[j] > v0) { v0 = el[j]; i0 = j; }
            int i1 = -1; float v1 = -3.0e38f;
#pragma unroll
            for (int j = 0; j < 4; ++j) if (j != i0 && el[j] > v1) { v1 = el[j]; i1 = j; }
            const float e1 = __expf(v1 - v0);
            const float w0 = pgrp / (1.f + e1), w1 = pgrp * e1 / (1.f + e1);
            const int lo = i0 < i1 ? i0 : i1, hi = i0 < i1 ? i1 : i0;
            const int pidx = (lo == 0) ? (hi - 1) : (lo == 1 ? (hi + 1) : 5);
            const int cat = gs * 6 + pidx;
            TokInfo info; info.cat = cat; info.w_lo = (i0 < i1) ? w0 : w1; info.w_hi = (i0 < i1) ? w1 : w0; info.rstd = rstd;
            ti[m] = info;
            const unsigned slot = atomicAdd(cnt + cat, 1u);
            lists[(size_t)cat * T + slot] = m;
        }
        asm volatile("s_waitcnt lgkmcnt(0)" ::: "memory");
    }
}
__device__ __forceinline__ void cat_experts(int cat, int& e_lo, int& e_hi) {
    const int g = cat / 6, p = cat % 6; int lo, hi;
    if (p < 3) { lo = 0; hi = p + 1; } else if (p < 5) { lo = 1; hi = p - 1; } else { lo = 2; hi = 3; }
    e_lo = g * 4 + lo; e_hi = g * 4 + hi;
}
__device__ __forceinline__ bool rowtile_lookup(const unsigned* cnt, int rt, int& cat, int& slot0, int& n) {
    int base = 0;
    for (int c = 0; c < NCAT; ++c) { const int nc = (int)__hip_atomic_load(cnt + c, __ATOMIC_RELAXED, __HIP_MEMORY_SCOPE_AGENT), ntile = (nc + 255) >> 8; if (rt < base + ntile) { cat = c; slot0 = (rt - base) * 256; n = nc; return true; } base += ntile; }
    cat = 0; slot0 = 0; n = 0; return false;
}
struct MUnit { int rt, pn, cat, slot0, n, e_lo, e_hi; };
struct PbMoe1 {
    typedef MUnit Unit;
    const char* X1; const char* W1; const int* lists; const unsigned* cnt; int G, c;
    __device__ __forceinline__ bool next(int i, Unit& u) const { const int L = i * G + c; u.rt = L >> 3; u.pn = L & 7; if (!rowtile_lookup(cnt, u.rt, u.cat, u.slot0, u.n)) return false; cat_experts(u.cat, u.e_lo, u.e_hi); return true; }
    __device__ __forceinline__ int nt() const { return D / 64; }
    __device__ __forceinline__ const char* a_base() const { return X1; }
    __device__ __forceinline__ unsigned ldb() const { return (unsigned)D; }
    __device__ __forceinline__ void a_offs(const Unit& u, const int (&R)[2], const int (&C)[2], unsigned (&o)[2][2]) const {
        const int* list = lists + (size_t)u.cat * T;
#pragma unroll
        for (int h = 0; h < 2; ++h)
#pragma unroll
            for (int i = 0; i < 2; ++i) { int sl = u.slot0 + h * 128 + R[i]; if (sl >= u.n) sl = u.slot0; o[h][i] = (unsigned)(list[sl] * D + C[i]) * 2u; } }
    __device__ __forceinline__ const char* b_ptr(const Unit& u, int t) const { const int e = (u.pn >> 2) ? u.e_hi : u.e_lo; return W1 + ((size_t)e * D + (size_t)(u.pn & 3) * 256) * D * 2 + (size_t)t * 128; }
};
struct EpiHid { static constexpr bool PERM = true; bf16_t* hid; const TokInfo* ti; const int* lists;
    __device__ __forceinline__ void operator()(const f32x4 (&acc)[2][2][4][2], const MUnit& u, int wr, int wc, int fr, int fq) const {
        const int* list = lists + (size_t)u.cat * T; const int kx = u.pn >> 2, col0 = kx * 512 + (u.pn & 3) * 128 + wc * 32 + 8 * fq;
#pragma unroll
        for (int ai = 0; ai < 2; ++ai)
#pragma unroll
            for (int m = 0; m < 4; ++m) { const int rl = ai * 128 + wr * 64 + m * 16 + fr, sl = u.slot0 + rl;
                if (sl < u.n) { const TokInfo t = ti[list[sl]]; const float w = kx ? t.w_hi : t.w_lo; f32x4 o[2];
#pragma unroll
                    for (int n = 0; n < 2; ++n)
#pragma unroll
                        for (int j = 0; j < 4; ++j) { const float g = acc[ai][0][m][n][j] * t.rstd, up = acc[ai][1][m][n][j] * t.rstd; o[n][j] = siluf_(g) * up * w; }
                    *(u32x4*)(hid + (size_t)(u.rt * 256 + rl) * D + col0) = pack8(o[0], o[1]); } } } };
__device__ __forceinline__ void phase_moe1(const Ptrs& P, LAS unsigned char* lds) {
    PbMoe1 pb{(const char*)(P.ws + WS_RB), (const char*)(P.ws + WS_W1), (const int*)(P.ws + WS_LIST), (const unsigned*)(P.ws + WS_CTL), (int)gridDim.x, (int)blockIdx.x};
    EpiHid ep{(bf16_t*)(P.ws + WS_HID), (const TokInfo*)(P.ws + WS_TOKI), (const int*)(P.ws + WS_LIST)};
    pg8::gemm_phase<PbMoe1, EpiHid, true>(lds, pb, ep);
}
struct PbMoe2 {
    typedef MUnit Unit;
    const char* HID; const char* W2; const unsigned* cnt; int G, c;
    __device__ __forceinline__ bool next(int i, Unit& u) const { const int L = i * G + c; u.rt = L >> 2; u.pn = L & 3; if (!rowtile_lookup(cnt, u.rt, u.cat, u.slot0, u.n)) return false; cat_experts(u.cat, u.e_lo, u.e_hi); return true; }
    __device__ __forceinline__ int nt() const { return D / 64; }
    __device__ __forceinline__ const char* a_base() const { return HID; }
    __device__ __forceinline__ unsigned ldb() const { return 2048u; }
    __device__ __forceinline__ void a_offs(const Unit& u, const int (&R)[2], const int (&C)[2], unsigned (&o)[2][2]) const {
#pragma unroll
        for (int h = 0; h < 2; ++h)
#pragma unroll
            for (int i = 0; i < 2; ++i) o[h][i] = (unsigned)((u.rt * 256 + h * 128 + R[i]) * D + C[i]) * 2u; }
    __device__ __forceinline__ const char* b_ptr(const Unit& u, int t) const {
        const int g = u.e_lo >> 2, el = (t < 8) ? (u.e_lo & 3) : (u.e_hi & 3);
        return W2 + ((size_t)g * D + (size_t)u.pn * 256) * 2048 * 2 + (size_t)el * 1024 + (size_t)(t & 7) * 128; }
};
struct EpiX2 { static constexpr bool PERM = true; const bf16_t* x1; bf16_t* x2; float* ssq; const int* lists;
    __device__ __forceinline__ void operator()(const f32x4 (&acc)[2][2][4][2], const MUnit& u, int wr, int wc, int fr, int fq) const {
        const int* list = lists + (size_t)u.cat * T; const int col0 = u.pn * 256 + wc * 32 + 8 * fq;
#pragma unroll
        for (int ai = 0; ai < 2; ++ai)
#pragma unroll
            for (int m = 0; m < 4; ++m) { const int rl = ai * 128 + wr * 64 + m * 16 + fr, sl = u.slot0 + rl; const bool v = sl < u.n; const int tok = list[v ? sl : u.slot0];
                const size_t off = (size_t)tok * D + col0; float sq = 0.f;
#pragma unroll
                for (int bj = 0; bj < 2; ++bj) { f32x4 r0, r1; unpack8(*(const u32x4*)(x1 + off + bj * 128), r0, r1); r0 += acc[ai][bj][m][0]; r1 += acc[ai][bj][m][1];
                    sq += sq4(r0) + sq4(r1); if (v) *(u32x4*)(x2 + off + bj * 128) = pack8(r0, r1); }
                sq += __shfl_xor(sq, 16); sq += __shfl_xor(sq, 32); if (fq == 0 && v) atomicAdd(ssq + tok, sq); } } };
__device__ __forceinline__ void phase_moe2(const Ptrs& P, LAS unsigned char* lds) {
    PbMoe2 pb{(const char*)(P.ws + WS_HID), (const char*)(P.ws + WS_W2), (const unsigned*)(P.ws + WS_CTL), (int)gridDim.x, (int)blockIdx.x};
    EpiX2 ep{(const bf16_t*)(P.ws + WS_RB), (bf16_t*)(P.ws + WS_X2), (float*)(P.ws + WS_SSQ3), (const int*)(P.ws + WS_LIST)};
    pg8::gemm_phase<PbMoe2, EpiX2, true>(lds, pb, ep);
}
struct EpiPP { static constexpr bool PERM = true; bf16_t* pp;
    __device__ __forceinline__ void operator()(const f32x4 (&acc)[2][2][4][2], const pg8::DUnit& u, int wr, int wc, int fr, int fq) const {
        const int row0 = u.pm * 256 + wr * 64 + fr, col0 = u.pn * 256 + wc * 32 + 8 * fq;
#pragma unroll
        for (int ai = 0; ai < 2; ++ai)
#pragma unroll
            for (int m = 0; m < 4; ++m) { bf16_t* rp = pp + (size_t)(row0 + ai * 128 + m * 16) * D + col0;
#pragma unroll
                for (int bj = 0; bj < 2; ++bj) *(u32x4*)(rp + bj * 128) = pack8(acc[ai][bj][m][0], acc[ai][bj][m][1]); } } };
struct EpiPle { static constexpr bool PERM = true; const bf16_t* x2; const bf16_t* pp; const float* ssq3; bf16_t* x3; float* ssq4;
    __device__ __forceinline__ void operator()(const f32x4 (&acc)[2][2][4][2], const pg8::DUnit& u, int wr, int wc, int fr, int fq) const {
        const int row0 = u.pm * 256 + wr * 64 + fr, col0 = u.pn * 256 + wc * 32 + 8 * fq;
#pragma unroll
        for (int ai = 0; ai < 2; ++ai)
#pragma unroll
            for (int m = 0; m < 4; ++m) { const int row = row0 + ai * 128 + m * 16; const size_t off = (size_t)row * D + col0; float sq = 0.f;
                const float rstd = rsqrtf(__hip_atomic_load(ssq3 + row, __ATOMIC_RELAXED, __HIP_MEMORY_SCOPE_AGENT) * (1.f / D) + EPS);
#pragma unroll
                for (int bj = 0; bj < 2; ++bj) { f32x4 a0, a1, p0, p1; unpack8(*(const u32x4*)(x2 + off + bj * 128), a0, a1); unpack8(*(const u32x4*)(pp + off + bj * 128), p0, p1);
#pragma unroll
                    for (int j = 0; j < 4; ++j) { a0[j] += sigmoidf_(acc[ai][bj][m][0][j] * rstd) * p0[j]; a1[j] += sigmoidf_(acc[ai][bj][m][1][j] * rstd) * p1[j]; }
                    sq += sq4(a0) + sq4(a1); *(u32x4*)(x3 + off + bj * 128) = pack8(a0, a1); }
                ssq_add(ssq4, row, sq, fq); } } };
__device__ __forceinline__ void phase_final(const Ptrs& P, int tid) {
    const int lane = tid & 63, gw = blockIdx.x * 8 + (tid >> 6), ngw = gridDim.x * 8;
    const bf16_t* x3 = (const bf16_t*)(P.ws + WS_X3); const float* ssq4 = (const float*)(P.ws + WS_SSQ4);
    for (int m = gw; m < T; m += ngw) {
        const float rstd = rsqrtf(ssq4[m] * (1.f / D) + EPS);
        for (int c = lane; c < D; c += 64) P.out[(size_t)m * D + c] = bf2f(x3[(size_t)m * D + c]) * rstd * P.g_final[c];
    }
}

__global__ void __launch_bounds__(NTHREADS, 2) mega_fwd(Ptrs P) {
    extern __shared__ __attribute__((aligned(16))) unsigned char lds_raw[];
    LAS unsigned char* lds = (LAS unsigned char*)lds_raw;
    const int tid = threadIdx.x;
    LAS unsigned* lctl = (LAS unsigned*)(lds + LDSCTL_OFF);
    for (int u = tid; u < 64; u += NTHREADS) lctl[u] = 0u;
    __syncthreads();
    XcdBarrier bar = xcd_barrier_post((unsigned*)(P.ws + WS_CTL) + CW_BAR, (volatile LAS unsigned*)(lctl + 8));

    phase_prep(P, lds, tid);
    xcd_barrier(bar);
    { pg8::PbDense pb; pb.init(P.ws + WS_RB, D, P.ws + WS_WIN, D, T, NPROJ, D); EpiProj ep{(bf16_t*)(P.ws + WS_PROJ), (const float*)(P.ws + WS_RSTD1)};
      pg8::gemm_phase<pg8::PbDense, EpiProj, true>(lds, pb, ep); }
    xcd_barrier(bar);
    phase_gla_a(P, lds, tid);
    xcd_barrier(bar);
    phase_gla_b(P, tid);
    xcd_barrier(bar);
    phase_gla_c(P, lds, tid);
    xcd_barrier(bar);
    { pg8::PbDense pb; pb.init(P.ws + WS_Y, D, P.ws + WS_WOUT, D, T, D, D); EpiOut ep{P.x, (bf16_t*)(P.ws + WS_RB), (float*)(P.ws + WS_SSQ2)};
      pg8::gemm_phase<pg8::PbDense, EpiOut, true>(lds, pb, ep); }
    xcd_barrier(bar);
    phase_route(P, lds, tid);
    xcd_barrier(bar);
    phase_moe1(P, lds);
    { pg8::PbDense pb; pb.init(P.ws + WS_PB, DPLE, P.ws + WS_WPP, DPLE, T, D, DPLE); EpiPP ep{(bf16_t*)(P.ws + WS_Y)};
      pg8::gemm_phase<pg8::PbDense, EpiPP, true>(lds, pb, ep); }
    xcd_barrier(bar);
    phase_moe2(P, lds);
    xcd_barrier(bar);
    { pg8::PbDense pb; pb.init(P.ws + WS_X2, D, P.ws + WS_WPG, D, T, D, D);
      EpiPle ep{(const bf16_t*)(P.ws + WS_X2), (const bf16_t*)(P.ws + WS_Y), (const float*)(P.ws + WS_SSQ3), (bf16_t*)(P.ws + WS_X3), (float*)(P.ws + WS_SSQ4)};
      pg8::gemm_phase<pg8::PbDense, EpiPle, true>(lds, pb, ep); }
    xcd_barrier(bar);
    phase_final(P, tid);
}

extern "C" void kernel_launch(void* const* d_in, const int* in_sizes, int n_in, void* d_out, int out_size, void* d_ws, size_t ws_size, hipStream_t stream) {
    static int grid = 0;
    if (grid == 0) {
        if (n_in != 21 || in_sizes[0] != T * D || out_size != T * D || ws_size < WS_END) {
            fprintf(stderr, "kernel_launch: unexpected shapes: n_in %d in0 %d out %d ws %zu\n", n_in, n_in > 0 ? in_sizes[0] : -1, out_size, ws_size); grid = -1; return; }
        int dev = 0, cus = 0, per_cu = 0;
        if (hipGetDevice(&dev) != hipSuccess || hipDeviceGetAttribute(&cus, hipDeviceAttributeMultiprocessorCount, dev) != hipSuccess) { grid = -1; return; }
        if (hipFuncSetAttribute((const void*)mega_fwd, hipFuncAttributeMaxDynamicSharedMemorySize, LDS_BYTES) != hipSuccess) { fprintf(stderr, "kernel_launch: hipFuncSetAttribute failed\n"); grid = -1; return; }
        if (hipOccupancyMaxActiveBlocksPerMultiprocessor(&per_cu, (const void*)mega_fwd, NTHREADS, LDS_BYTES) != hipSuccess || per_cu < 1) {
            fprintf(stderr, "kernel_launch: occupancy query says %d workgroups per CU; not launching\n", per_cu); grid = -1; return; }
        (void)hipGetLastError();
        grid = cus;
    }
    if (grid < 0) return;
    Ptrs P{};
    const float** pp = (const float**)&P;
    for (int i = 0; i < 21; ++i) pp[i] = (const float*)d_in[i];
    P.out = (float*)d_out; P.ws = (unsigned char*)d_ws;
    if (hipMemsetAsync((char*)d_ws + WS_CTL, 0, CTL_BYTES, stream) != hipSuccess) { fprintf(stderr, "kernel_launch: memset failed\n"); return; }
    hipLaunchKernelGGL(mega_fwd, dim3(grid), dim3(NTHREADS), LDS_BYTES, stream, P);
}
```

```cpp
#include <hip/hip_runtime.h>
#include <cstdio>
#include <cstdint>

typedef unsigned short bf16_t;
typedef short bf16x8 __attribute__((ext_vector_type(8)));
typedef float f32x4 __attribute__((ext_vector_type(4)));
typedef unsigned u32x4 __attribute__((ext_vector_type(4)));
typedef unsigned u32x2 __attribute__((ext_vector_type(2)));
#define LAS __attribute__((address_space(3)))

constexpr int D = 1024, NB = 2, S = 8192, T = NB * S, DPLE = 256;
constexpr int H = 4, DK = 64, DV = 128, LR = 16, QK = 256, GV = 512, CW = 512;
constexpr int DIN = 3088, NPROJ = 3072;
constexpr int NE = 16, DE = 512, NCAT = 24;
constexpr float EPS = 1e-6f;
constexpr int PQ = 0, PK = 256, PV = 512, PG = 1024, PB = 1536, PC = 2048, PU = 2560;
constexpr int MAXRT = 88;
constexpr int NTHREADS = 512;
#ifndef PROBE_DUP
#define PROBE_DUP (-1)
#endif
#ifndef PROBE_REP
#define PROBE_REP 1
#endif

constexpr size_t MiB = 1u << 20;
constexpr size_t WS_CTL = 0, CTL_BYTES = 1 * MiB;
constexpr int CW_BAR = 4096;
constexpr size_t WS_SSQ2 = 63 * MiB + 256 * 1024;
constexpr size_t WS_SSQ3 = WS_SSQ2 + 256 * 1024;
constexpr size_t WS_SSQ4 = WS_SSQ3 + 256 * 1024;
constexpr size_t WS_WIN = 1 * MiB;
constexpr size_t WS_WOUT = 7 * MiB;
constexpr size_t WS_WPG = 9 * MiB;
constexpr size_t WS_WPP = 11 * MiB;
constexpr size_t WS_WA = 11 * MiB + 512 * 1024;
constexpr size_t WS_WR = 11 * MiB + 768 * 1024;
constexpr size_t WS_W1 = 12 * MiB;
constexpr size_t WS_W2 = 44 * MiB;
constexpr size_t WS_SMALL = 60 * MiB;
constexpr size_t WS_RSTD1 = WS_SMALL;
constexpr size_t WS_ALOW = WS_SMALL + 64 * 1024;
constexpr size_t WS_TOKI = WS_ALOW + 1 * MiB;
constexpr size_t WS_LIST = WS_TOKI + 256 * 1024;
constexpr size_t WS_DEC = 63 * MiB;
constexpr size_t WS_ST = 232 * MiB;
constexpr size_t WS_RB = 64 * MiB;
constexpr size_t WS_PB = 96 * MiB;
constexpr size_t WS_PROJ = 104 * MiB;
constexpr size_t WS_HID = WS_PROJ;
constexpr size_t WS_X2 = WS_PROJ + 44 * MiB;
constexpr size_t WS_Y = 200 * MiB;
constexpr size_t WS_X3 = WS_RB;
constexpr size_t WS_END = 256 * MiB;
static_assert(WS_LIST + (size_t)NCAT * T * 4 <= WS_RB, "small arrays fit");
static_assert(WS_Y + (size_t)T * D * 2 <= WS_END && WS_X2 + (size_t)T * D * 2 <= WS_Y, "map");

constexpr int LDS_BYTES = 147456;
constexpr int LDSCTL_OFF = 131072;
constexpr int LDS_PART_OFF = LDSCTL_OFF + 1024;
constexpr int LDS_RTT_OFF = LDS_PART_OFF + 4096;

struct TokInfo { int cat; float w_lo, w_hi, rstd; };

__device__ __forceinline__ float bf2f(bf16_t v) { return __uint_as_float(((unsigned)v) << 16); }
__device__ __forceinline__ bf16_t f2bf(float f) { unsigned u = __float_as_uint(f); return (bf16_t)((u + 0x7fffu + ((u >> 16) & 1u)) >> 16); }
__device__ __forceinline__ unsigned pk2(float lo, float hi) { return (unsigned)f2bf(lo) | ((unsigned)f2bf(hi) << 16); }
__device__ __forceinline__ float wave_sum(float v) {
#pragma unroll
    for (int o = 1; o < 64; o <<= 1) v += __shfl_xor(v, o);
    return v;
}
__device__ __forceinline__ float sigmoidf_(float x) { return 1.0f / (1.0f + __expf(-x)); }
__device__ __forceinline__ float siluf_(float x) { return x * sigmoidf_(x); }
__device__ __forceinline__ float logsigmoidf_(float x) { return fminf(x, 0.f) - log1pf(__expf(-fabsf(x))); }

__device__ __forceinline__ unsigned cvt_pk_bf16(float lo, float hi) { unsigned r; asm volatile("v_cvt_pk_bf16_f32 %0, %1, %2" : "=v"(r) : "v"(lo), "v"(hi)); return r; }
__device__ __forceinline__ float ssq_unit_rows(LAS float* s_part, const float (&sq)[2][4], int wr, int wc, int fr, int fq) {
#pragma unroll
    for (int ai = 0; ai < 2; ++ai)
#pragma unroll
        for (int m = 0; m < 4; ++m) { float v = sq[ai][m]; v += __shfl_xor(v, 16); v += __shfl_xor(v, 32); if (fq == 0) s_part[(ai * 128 + wr * 64 + m * 16 + fr) * 4 + wc] = v; }
    asm volatile("s_waitcnt lgkmcnt(0)" ::: "memory"); __builtin_amdgcn_s_barrier(); asm volatile("" ::: "memory");
    float tot = 0.f;
    if (threadIdx.x < 256) { const f32x4 p4 = *(const LAS f32x4*)(s_part + threadIdx.x * 4); tot = (p4.x + p4.y) + (p4.z + p4.w); }
    return tot;
}
__device__ __forceinline__ float rstd_from_parts(const float* ssq, int row) { const f32x4 p4 = *(const f32x4*)(ssq + (size_t)row * 4); return rsqrtf(((p4.x + p4.y) + (p4.z + p4.w)) * (1.f / D) + EPS); }
__device__ __forceinline__ float sq4(const f32x4& v) { return (v[0] * v[0] + v[1] * v[1]) + (v[2] * v[2] + v[3] * v[3]); }
__device__ __forceinline__ u32x4 pack8(const f32x4& a, const f32x4& b) { u32x4 w; w.x = cvt_pk_bf16(a[0], a[1]); w.y = cvt_pk_bf16(a[2], a[3]); w.z = cvt_pk_bf16(b[0], b[1]); w.w = cvt_pk_bf16(b[2], b[3]); return w; }
__device__ __forceinline__ void unpack8(const u32x4& w, f32x4& a, f32x4& b) {
    a[0] = __uint_as_float(w.x << 16); a[1] = __uint_as_float(w.x & 0xffff0000u); a[2] = __uint_as_float(w.y << 16); a[3] = __uint_as_float(w.y & 0xffff0000u);
    b[0] = __uint_as_float(w.z << 16); b[1] = __uint_as_float(w.z & 0xffff0000u); b[2] = __uint_as_float(w.w << 16); b[3] = __uint_as_float(w.w & 0xffff0000u); }

__device__ __forceinline__ int opq(int t) { asm volatile("" : "+v"(t)); return t; }
struct Ptrs {
    const float *x, *p, *g_mix, *w_in, *w_gla_gate, *b_gla_gate, *g_gla_out, *w_conv, *w_out, *g_moe, *w_group, *b_group, *w_router, *b_router,
        *w_exp_gate, *w_exp_up, *w_exp_down, *g_ple, *w_ple_gate, *w_ple_proj, *g_final;
    float* out; unsigned char* ws;
};

#define XB_TMO      128
#define XB_XCNT(j)  (256  + 64 * (j))
#define XB_XSUB(j)  (1280 + 64 * (j))
#define XB_XGEN(j)  (2304 + 64 * (j))
#define XB_TOP      3328
#define XB_TOPGEN   3392
#define XCD_BAR_WORDS 3456
#define XB_SPIN_CAP (1u << 18)
__device__ __forceinline__ unsigned xb_ld(unsigned* p)              { return __hip_atomic_load(p, __ATOMIC_RELAXED, __HIP_MEMORY_SCOPE_AGENT); }
__device__ __forceinline__ unsigned xb_add(unsigned* p, unsigned v) { return __hip_atomic_fetch_add(p, v, __ATOMIC_RELAXED, __HIP_MEMORY_SCOPE_AGENT); }
__device__ __forceinline__ unsigned xb_xcc_id() { return (unsigned)__builtin_amdgcn_s_getreg((3 << 11) | 20) & 0xFu; }
#define XB_SPIN(cond, bar) do { unsigned _sp = 0; while (cond) { __builtin_amdgcn_s_sleep(1); \
    if ((++_sp & 255u) == 0u) { if (xb_ld(&(bar)[XB_TMO])) break; if (_sp > XB_SPIN_CAP) { atomicAdd(&(bar)[XB_TMO], 1u); break; } } } } while (0)
struct XcdBarrier { unsigned* bar; unsigned x; volatile LAS unsigned* st; };
__device__ __forceinline__ XcdBarrier xcd_barrier_post(unsigned* bar, volatile LAS unsigned* st) {
    XcdBarrier b; b.bar = bar; b.x = xb_xcc_id(); b.st = st;
    if (threadIdx.x == 0) (void)xb_add(&bar[XB_XCNT(b.x)], 1u);
    return b;
}
__device__ __forceinline__ void xcd_barrier_complete(unsigned* bar, unsigned x, unsigned& nloc, unsigned& nx) {
    const unsigned G = gridDim.x * gridDim.y * gridDim.z;
    unsigned sum, cnt, mine, sp = 0u;
    for (;;) {
        sum = 0u; cnt = 0u; mine = 0u;
#pragma unroll
        for (unsigned j = 0; j < 16; ++j) { const unsigned c = xb_ld(&bar[XB_XCNT(j)]); sum += c; cnt += (c > 0u) ? 1u : 0u; mine = (j == x) ? c : mine; }
        if (sum == G) break;
        __builtin_amdgcn_s_sleep(1);
        if ((++sp & 255u) == 0u) { if (xb_ld(&bar[XB_TMO])) break; if (sp > XB_SPIN_CAP) { atomicAdd(&bar[XB_TMO], 1u); break; } }
    }
    nloc = mine > 0u ? mine : 1u; nx = cnt > 0u ? cnt : 1u;
}
__device__ __forceinline__ void xcd_barrier(const XcdBarrier& b) {
    asm volatile("s_waitcnt vmcnt(0)" ::: "memory");
    __syncthreads();
    if (threadIdx.x == 0) {
        unsigned* bar = b.bar;
        __builtin_amdgcn_s_waitcnt(0);
        unsigned nloc = b.st[0], nx = b.st[1];
        if (nloc == 0u) { xcd_barrier_complete(bar, b.x, nloc, nx); b.st[0] = nloc; b.st[1] = nx; }
        const unsigned old = xb_add(&bar[XB_XSUB(b.x)], 1u);
        const unsigned gen = old / nloc;
        if (old + 1u == (gen + 1u) * nloc) {
            __builtin_amdgcn_fence(__ATOMIC_RELEASE, "agent");
            asm volatile("s_waitcnt vmcnt(0)" ::: "memory");
            const unsigned og = xb_add(&bar[XB_TOP], 1u);
            const unsigned tg = og / nx;
            if (og + 1u == (tg + 1u) * nx) xb_add(&bar[XB_TOPGEN], 1u);
            else XB_SPIN(xb_ld(&bar[XB_TOPGEN]) == tg, bar);
            __builtin_amdgcn_fence(__ATOMIC_ACQUIRE, "agent");
            xb_add(&bar[XB_XGEN(b.x)], 1u);
            asm volatile("s_waitcnt vmcnt(0)" ::: "memory");
        } else {
            XB_SPIN(xb_ld(&bar[XB_XGEN(b.x)]) == gen, bar);
            __builtin_amdgcn_fence(__ATOMIC_ACQUIRE, "agent");
            asm volatile("s_waitcnt vmcnt(0)" ::: "memory");
        }
    }
    __syncthreads();
}

constexpr int TL_WIN = (D / 64) * (NPROJ / 256), TL_SQ = (D / 64) * (D / 256), TL_WPP = (DPLE / 64) * (D / 256), TL_W1 = (D / 64) * (DE / 256), TL_W2 = (DE / 64) * (D / 256);
constexpr int TLB_WOUT = TL_WIN, TLB_WPG = TLB_WOUT + TL_SQ, TLB_WPP = TLB_WPG + TL_SQ, TLB_W1 = TLB_WPP + TL_WPP, TLB_W2 = TLB_W1 + 32 * TL_W1, TL_TOTAL = TLB_W2 + 16 * TL_W2;
struct TileJob { const float* src; const float* gain; bf16_t* dst; int ldw, ldt, k0, nsrc0, n0, half; };
__device__ __forceinline__ TileJob tile_job(const Ptrs& P, int it) {
    TileJob j;
    if (it < TLB_WOUT) { const int kb = it / (NPROJ / 256), nb = it % (NPROJ / 256), n0 = nb * 256; j = TileJob{P.w_in, P.g_mix, (bf16_t*)(P.ws + WS_WIN), DIN, D, kb * 64, n0 < 1536 ? n0 : n0 + 16, n0, -1}; }
    else if (it < TLB_WPG) { const int r = it - TLB_WOUT; j = TileJob{P.w_out, nullptr, (bf16_t*)(P.ws + WS_WOUT), D, D, (r / 4) * 64, (r % 4) * 256, (r % 4) * 256, -1}; }
    else if (it < TLB_WPP) { const int r = it - TLB_WPG; j = TileJob{P.w_ple_gate, P.g_ple, (bf16_t*)(P.ws + WS_WPG), D, D, (r / 4) * 64, (r % 4) * 256, (r % 4) * 256, -1}; }
    else if (it < TLB_W1) { const int r = it - TLB_WPP; j = TileJob{P.w_ple_proj, nullptr, (bf16_t*)(P.ws + WS_WPP), D, DPLE, (r / 4) * 64, (r % 4) * 256, (r % 4) * 256, -1}; }
    else if (it < TLB_W2) { const int q = it - TLB_W1, jj = q / TL_W1, r = q % TL_W1, e = jj >> 1, half = jj & 1;
        j = TileJob{(half ? P.w_exp_up : P.w_exp_gate) + (size_t)e * D * DE, P.g_moe, (bf16_t*)(P.ws + WS_W1) + (size_t)e * D * D, DE, D, (r / 2) * 64, (r % 2) * 256, (r % 2) * 256, half}; }
    else { const int q = it - TLB_W2, e = q / TL_W2, r = q % TL_W2, g = e >> 2, el = e & 3;
        j = TileJob{P.w_exp_down + (size_t)e * DE * D, nullptr, (bf16_t*)(P.ws + WS_W2) + (size_t)g * D * 2048 + el * DE, D, 2048, (r / 4) * 64, (r % 4) * 256, (r % 4) * 256, -1}; }
    return j;
}
__device__ __forceinline__ void tile_load(const TileJob& j, f32x4 (&v)[8], int tid) {
    const int c4 = (tid & 63) * 4, pw = tid >> 6;
#pragma unroll
    for (int ii = 0; ii < 4; ++ii)
#pragma unroll
        for (int h = 0; h < 2; ++h) { const int kk = 2 * (pw + 8 * ii) + h; f32x4 t = *(const f32x4*)(j.src + (size_t)(j.k0 + kk) * j.ldw + j.nsrc0 + c4); if (j.gain) t = t * j.gain[j.k0 + kk]; v[2 * ii + h] = t; }
}
__device__ __forceinline__ void phase_prep(const Ptrs& P, LAS unsigned char* lds, int tid) {
    const int lane = tid & 63, wid = tid >> 6, gw = blockIdx.x * 8 + wid, ngw = gridDim.x * 8;
    __syncthreads();
    LAS float* s_wa = (LAS float*)lds;
    for (int k = tid; k < D; k += NTHREADS) { const float g = P.g_mix[k]; const f32x4* src = (const f32x4*)(P.w_in + (size_t)k * DIN + 1536);
#pragma unroll
        for (int q = 0; q < 4; ++q) { const f32x4 v = src[q] * g; s_wa[(4 * q + 0) * D + k] = v.x; s_wa[(4 * q + 1) * D + k] = v.y; s_wa[(4 * q + 2) * D + k] = v.z; s_wa[(4 * q + 3) * D + k] = v.w; } }
    __syncthreads();
    bf16_t* xb = (bf16_t*)(P.ws + WS_RB); float* rstd1 = (float*)(P.ws + WS_RSTD1); bf16_t* pb = (bf16_t*)(P.ws + WS_PB); float* alow = (float*)(P.ws + WS_ALOW);
    { f32x4 vn[4], pn;
      if (gw < T) { const f32x4* xr = (const f32x4*)(P.x + (size_t)gw * D) + lane;
#pragma unroll
          for (int j = 0; j < 4; ++j) vn[j] = xr[64 * j];
          pn = ((const f32x4*)(P.p + (size_t)gw * DPLE))[lane]; }
      for (int m = gw; m < T; m += ngw) {
        f32x4 v[4]; float ss = 0.f;
#pragma unroll
        for (int j = 0; j < 4; ++j) { v[j] = vn[j]; ss += sq4(v[j]); }
        const f32x4 pv = pn;
        if (m + ngw < T) { const f32x4* xr = (const f32x4*)(P.x + (size_t)(m + ngw) * D) + lane;
#pragma unroll
            for (int j = 0; j < 4; ++j) vn[j] = xr[64 * j];
            pn = ((const f32x4*)(P.p + (size_t)(m + ngw) * DPLE))[lane]; }
        float a[LR];
#pragma unroll
        for (int jj = 0; jj < LR; ++jj) { float t = 0.f;
#pragma unroll
            for (int j = 0; j < 4; ++j) { const f32x4 w4 = *(const LAS f32x4*)(s_wa + jj * D + 256 * j + 4 * lane); t += (v[j].x * w4.x + v[j].y * w4.y) + (v[j].z * w4.z + v[j].w * w4.w); }
            a[jj] = t; if ((jj & 3) == 3) asm volatile("" ::: "memory"); }
#pragma unroll
        for (int i = 0; i < 8; ++i) { const bool hi = lane & 32; const float keep = hi ? a[i + 8] : a[i], send = hi ? a[i] : a[i + 8]; a[i] = keep + __shfl_xor(send, 32); }
#pragma unroll
        for (int i = 0; i < 4; ++i) { const bool hi = lane & 16; const float keep = hi ? a[i + 4] : a[i], send = hi ? a[i] : a[i + 4]; a[i] = keep + __shfl_xor(send, 16); }
#pragma unroll
        for (int i = 0; i < 2; ++i) { const bool hi = lane & 8; const float keep = hi ? a[i + 2] : a[i], send = hi ? a[i] : a[i + 2]; a[i] = keep + __shfl_xor(send, 8); }
        { const bool hi = lane & 4; const float keep = hi ? a[1] : a[0], send = hi ? a[0] : a[1]; a[0] = keep + __shfl_xor(send, 4); }
        a[0] += __shfl_xor(a[0], 2); a[0] += __shfl_xor(a[0], 1);
        ss = wave_sum(ss);
        const float rstd = rsqrtf(ss * (1.f / D) + EPS);
        if ((lane & 3) == 0) alow[(size_t)m * LR + (lane >> 2)] = a[0] * rstd;
        if (lane == 0) rstd1[m] = rstd;
        u32x2* o = (u32x2*)(xb + (size_t)m * D) + lane;
#pragma unroll
        for (int j = 0; j < 4; ++j) { u32x2 w; w.x = pk2(v[j].x, v[j].y); w.y = pk2(v[j].z, v[j].w); o[64 * j] = w; }
        u32x2 w; w.x = pk2(pv.x, pv.y); w.y = pk2(pv.z, pv.w);
        ((u32x2*)(pb + (size_t)m * DPLE))[lane] = w;
      } }
    LAS unsigned* st = (LAS unsigned*)lds;
    { const int G = gridDim.x; int it = blockIdx.x; TileJob ja{}, jb{}; f32x4 va[8], vb[8];
      if (it < TL_TOTAL) { ja = tile_job(P, it); tile_load(ja, va, tid); }
      if (it + G < TL_TOTAL) { jb = tile_job(P, it + G); tile_load(jb, vb, tid); }
#define PREP_TILE(J, V, NEXT_IT) do { \
        __syncthreads(); \
        { const int c4 = (tid & 63) * 4, pw = tid >> 6; \
          _Pragma("unroll") for (int ii = 0; ii < 4; ++ii) { const int pr = pw + 8 * ii; \
              _Pragma("unroll") for (int jn = 0; jn < 4; ++jn) st[(c4 + jn) * 34 + pr] = pk2(V[2 * ii][jn], V[2 * ii + 1][jn]); } } \
        __syncthreads(); \
        const TileJob done = J; \
        if ((NEXT_IT) < TL_TOTAL) { J = tile_job(P, (NEXT_IT)); tile_load(J, V, tid); } \
        { const int n = tid >> 1, half = tid & 1; const LAS u32x2* rp = (const LAS u32x2*)(st + n * 34 + half * 16); \
          const int row = (done.half < 0) ? (done.n0 + n) : ((((done.n0 + n) >> 7) << 8) + done.half * 128 + (n & 127)); \
          bf16_t* dp = done.dst + (size_t)row * done.ldt + done.k0 + half * 32; \
          _Pragma("unroll") for (int q = 0; q < 4; ++q) { const u32x2 r0 = rp[2 * q], r1 = rp[2 * q + 1]; u32x4 o; o.x = r0.x; o.y = r0.y; o.z = r1.x; o.w = r1.y; *(u32x4*)(dp + 8 * q) = o; } } } while (0)
      while (it < TL_TOTAL) {
        PREP_TILE(ja, va, it + 2 * G);
        if (it + G < TL_TOTAL) PREP_TILE(jb, vb, it + 3 * G);
        it += 2 * G;
      }
#undef PREP_TILE
    }
    bf16_t* WRh = (bf16_t*)(P.ws + WS_WR); bf16_t* WRl = WRh + 32 * D;
    for (int i = blockIdx.x * NTHREADS + tid; i < 32 * D; i += gridDim.x * NTHREADS) { const int j = i / D, k = i % D; float v = 0.f;
        if (j < 20) v = P.g_moe[k] * (j < 4 ? P.w_group[k * 4 + j] : P.w_router[k * NE + (j - 4)]);
        const bf16_t hi = f2bf(v); WRh[i] = hi; WRl[i] = f2bf(v - bf2f(hi)); }
}

namespace pg8 {
constexpr int BM = 256, BK = 64, HALF = 128, HTB = HALF * BK * 2, STAGE_BYTES = 8 * HTB, NXCD = 8, WGM = 8;
__device__ __forceinline__ int lds_byte(int r, int c) { const int st = (r >> 4) * 2 + (c >> 5), rr = r & 15, cc = c & 31, ob = rr * 64 + cc * 2; return st * 1024 + (ob ^ (((ob >> 9) & 1) << 5)); }
__device__ __forceinline__ void stage_rc(int b, int& R, int& C) { const int st = b / 1024, sb = b % 1024, swz = sb ^ (((sb >> 9) & 1) << 5); R = (st >> 1) * 16 + swz / 64; C = (st & 1) * 32 + (swz % 64) / 2; }
__device__ __forceinline__ int perm32(int rho) { const int n = rho >> 4, i = rho & 15; return 8 * (i >> 2) + 4 * n + (i & 3); }

struct StaticOrder {
    int nM, nN, nwg, G, c;
    __device__ void init(int M, int N, int G_, int c_) { nM = M / BM; nN = N / BM; nwg = nM * nN; G = G_; c = c_; }
    __device__ bool next(int i, int& pm, int& pn) const {
        const long L = (long)i * G + c; if (L >= nwg) return false;
        int wgid = (int)L; { const int q = nwg / NXCD, r = nwg % NXCD, xcd = wgid % NXCD, off = wgid / NXCD; wgid = (xcd < r ? xcd * (q + 1) : r * (q + 1) + (xcd - r) * q) + off; }
        const int nig = WGM * nN, gid = wgid / nig, fm = gid * WGM, gsz = (nM - fm) < WGM ? (nM - fm) : WGM;
        pm = fm + ((wgid % nig) % gsz); pn = (wgid % nig) / gsz; return true;
    }
};

template <class Pb, class Epi, bool ALIGN_EPI>
__device__ __forceinline__ void gemm_phase(LAS unsigned char* lds, const Pb& S, const Epi& E) {
    int tid_ = threadIdx.x; asm volatile("" : "+v"(tid_));
    const int tid = tid_, wid = __builtin_amdgcn_readfirstlane(tid >> 6), lane = tid & 63, wr = wid >> 2, wc = wid & 3, fr = lane & 15, fq = lane >> 4;
    const int nt = S.nt();
    int R[2], C[2]; unsigned voffB[2];
#pragma unroll
    for (int i = 0; i < 2; ++i) { stage_rc(tid * 16 + i * 8192, R[i], C[i]); const int Rb = Epi::PERM ? ((R[i] & ~31) + perm32(R[i] & 31)) : R[i]; voffB[i] = (unsigned)(Rb * (int)S.ldb() + C[i]) * 2u; }
    const size_t hstepB = (size_t)HALF * S.ldb() * 2;
    const unsigned ldsw = (unsigned)wid * 1024u;
    const int aoff = lds_byte(wr * 64 + fr, fq * 8), boff = lds_byte(wc * 32 + fr, fq * 8);
    const char* const abase = S.a_base();
#define PG8_SA(b, h) (((b) * 2 + (h)) * HTB)
#define PG8_SB(b, h) ((4 + (b) * 2 + (h)) * HTB)
#define PG8_STAGE_B(bufoff, gbase) do { _Pragma("unroll") for (int _i = 0; _i < 2; ++_i) \
        __builtin_amdgcn_global_load_lds((const unsigned*)((const char*)(gbase) + voffB[_i]), (LAS unsigned*)(lds + (bufoff) + ldsw + _i * 8192), 16, 0, 0); } while (0)
#define PG8_STAGE_A(bufoff, kbase, o0, o1) do { \
        __builtin_amdgcn_global_load_lds((const unsigned*)((kbase) + (o0)), (LAS unsigned*)(lds + (bufoff) + ldsw), 16, 0, 0); \
        __builtin_amdgcn_global_load_lds((const unsigned*)((kbase) + (o1)), (LAS unsigned*)(lds + (bufoff) + ldsw + 8192), 16, 0, 0); } while (0)
#define PG8_LDA(dst, b, h) do { _Pragma("unroll") for (int m = 0; m < 4; ++m) _Pragma("unroll") for (int k = 0; k < 2; ++k) dst[m][k] = *(const LAS bf16x8*)(lds + PG8_SA(b, h) + aoff + m * 2048 + k * 1024); } while (0)
#define PG8_LDB(dst, b, h) do { _Pragma("unroll") for (int n = 0; n < 2; ++n) _Pragma("unroll") for (int k = 0; k < 2; ++k) dst[n][k] = *(const LAS bf16x8*)(lds + PG8_SB(b, h) + boff + n * 2048 + k * 1024); } while (0)
#define PG8_MMA(ai, bj, At, Bt) do { __builtin_amdgcn_s_setprio(1); _Pragma("unroll") for (int m = 0; m < 4; ++m) _Pragma("unroll") for (int n = 0; n < 2; ++n) _Pragma("unroll") for (int k = 0; k < 2; ++k) \
        acc[ai][bj][m][n] = __builtin_amdgcn_mfma_f32_16x16x32_bf16(Bt[n][k], At[m][k], acc[ai][bj][m][n], 0, 0, 0); __builtin_amdgcn_s_setprio(0); } while (0)
#define PG8_WAIT_V(n) asm volatile("s_waitcnt vmcnt(" #n ")" ::: "memory")
#define PG8_WAIT_L(n) asm volatile("s_waitcnt lgkmcnt(" #n ")" ::: "memory")
#define PG8_BAR __builtin_amdgcn_s_barrier()
#define PG8_SCHED __builtin_amdgcn_sched_barrier(0)
    typename Pb::Unit cur, nxt; int ui = 0;
    if (!S.next(0, cur)) return;
    f32x4 acc[2][2][4][2];
#pragma unroll
    for (int a = 0; a < 2; ++a)
#pragma unroll
        for (int b = 0; b < 2; ++b)
#pragma unroll
            for (int m = 0; m < 4; ++m)
#pragma unroll
                for (int n = 0; n < 2; ++n) acc[a][b][m][n] = (f32x4){0.f, 0.f, 0.f, 0.f};
    bf16x8 At[4][2], B0[2][2], B1[2][2];
    unsigned aoc[2][2], aon[2][2];
    S.a_offs(cur, R, C, aoc);
    { const char* b0 = S.b_ptr(cur, 0); const char* b1 = S.b_ptr(cur, 1);
      PG8_STAGE_B(PG8_SB(0, 0), b0); PG8_STAGE_B(PG8_SB(0, 1), b0 + hstepB); PG8_STAGE_A(PG8_SA(0, 0), abase, aoc[0][0], aoc[0][1]); PG8_STAGE_A(PG8_SA(0, 1), abase, aoc[1][0], aoc[1][1]);
      if (wr == 1) PG8_BAR;
      PG8_WAIT_V(2); PG8_BAR;
      PG8_STAGE_B(PG8_SB(1, 0), b1); PG8_STAGE_A(PG8_SA(1, 0), abase + 128, aoc[0][0], aoc[0][1]); PG8_STAGE_B(PG8_SB(1, 1), b1 + hstepB);
      PG8_WAIT_V(6); PG8_BAR; }
    for (;;) {
        const bool has_next = S.next(ui + 1, nxt);
        if (has_next) S.a_offs(nxt, R, C, aon); else { nxt = cur; aon[0][0] = aoc[0][0]; aon[0][1] = aoc[0][1]; aon[1][0] = aoc[1][0]; aon[1][1] = aoc[1][1]; }
        for (int t = 0; t < nt; t += 2) {
            const bool last = (t == nt - 2);
            const char* ak1 = abase + (size_t)(t + 1) * 128;
            const char* ak2 = last ? abase : abase + (size_t)(t + 2) * 128;
            const char* ak3 = ak2 + 128;
            const char* b2 = last ? S.b_ptr(nxt, 0) : S.b_ptr(cur, t + 2); const char* b3 = last ? S.b_ptr(nxt, 1) : S.b_ptr(cur, t + 3);
            const unsigned o00 = last ? aon[0][0] : aoc[0][0], o01 = last ? aon[0][1] : aoc[0][1], o10 = last ? aon[1][0] : aoc[1][0], o11 = last ? aon[1][1] : aoc[1][1];
            PG8_LDB(B0, 0, 0); PG8_LDB(B1, 0, 1); PG8_SCHED; PG8_LDA(At, 0, 0); PG8_STAGE_A(PG8_SA(1, 1), ak1, aoc[1][0], aoc[1][1]);
            PG8_WAIT_V(8); PG8_WAIT_L(0); PG8_BAR; PG8_MMA(0, 0, At, B0); PG8_MMA(0, 1, At, B1); PG8_BAR; PG8_SCHED;
            PG8_LDA(At, 0, 1); PG8_STAGE_B(PG8_SB(0, 0), b2); PG8_STAGE_B(PG8_SB(0, 1), b2 + hstepB); PG8_STAGE_A(PG8_SA(0, 0), ak2, o00, o01);
            PG8_WAIT_V(8); PG8_WAIT_L(0); PG8_BAR; PG8_MMA(1, 0, At, B0); PG8_MMA(1, 1, At, B1); PG8_BAR; PG8_SCHED;
            PG8_LDB(B0, 1, 0); PG8_LDB(B1, 1, 1); PG8_SCHED; PG8_LDA(At, 1, 0); PG8_STAGE_A(PG8_SA(0, 1), ak2, o10, o11);
            PG8_WAIT_V(8); PG8_WAIT_L(0); PG8_BAR; PG8_MMA(0, 0, At, B0); PG8_MMA(0, 1, At, B1); PG8_BAR; PG8_SCHED;
            PG8_LDA(At, 1, 1); PG8_STAGE_B(PG8_SB(1, 0), b3); PG8_STAGE_B(PG8_SB(1, 1), b3 + hstepB); PG8_STAGE_A(PG8_SA(1, 0), ak3, o00, o01);
            PG8_WAIT_V(8); PG8_WAIT_L(0); PG8_BAR; PG8_MMA(1, 0, At, B0); PG8_MMA(1, 1, At, B1); PG8_BAR; PG8_SCHED;
        }
        if constexpr (ALIGN_EPI) { if (wr == 0) PG8_BAR; }
        E(acc, cur, wr, wc, fr, fq);
        if (!has_next) break;
#pragma unroll
        for (int a = 0; a < 2; ++a)
#pragma unroll
            for (int b = 0; b < 2; ++b)
#pragma unroll
                for (int m = 0; m < 4; ++m)
#pragma unroll
                    for (int n = 0; n < 2; ++n) acc[a][b][m][n] = (f32x4){0.f, 0.f, 0.f, 0.f};
        cur = nxt; aoc[0][0] = aon[0][0]; aoc[0][1] = aon[0][1]; aoc[1][0] = aon[1][0]; aoc[1][1] = aon[1][1]; ++ui;
        if constexpr (ALIGN_EPI) { if (wr == 1) PG8_BAR; }
    }
    PG8_WAIT_V(0);
    if constexpr (!ALIGN_EPI) { if (wr == 0) PG8_BAR; }
    PG8_BAR;
#undef PG8_SA
#undef PG8_SB
#undef PG8_STAGE_A
#undef PG8_STAGE_B
#undef PG8_LDA
#undef PG8_LDB
#undef PG8_MMA
#undef PG8_WAIT_V
#undef PG8_WAIT_L
#undef PG8_BAR
#undef PG8_SCHED
}

struct DUnit { int pm, pn; };
struct PbDense {
    typedef DUnit Unit;
    const char* A; const char* Bt; int lda, ldb_, K; StaticOrder so;
    __device__ void init(const void* A_, int lda_, const void* Bt_, int ldb__, int M, int N, int K_) { A = (const char*)A_; Bt = (const char*)Bt_; lda = lda_; ldb_ = ldb__; K = K_; so.init(M, N, gridDim.x, blockIdx.x); }
    __device__ __forceinline__ bool next(int i, Unit& u) const { return so.next(i, u.pm, u.pn); }
    __device__ __forceinline__ int nt() const { return K / BK; }
    __device__ __forceinline__ const char* a_base() const { return A; }
    __device__ __forceinline__ unsigned ldb() const { return (unsigned)ldb_; }
    __device__ __forceinline__ void a_offs(const Unit& u, const int (&R)[2], const int (&C)[2], unsigned (&o)[2][2]) const {
#pragma unroll
        for (int h = 0; h < 2; ++h)
#pragma unroll
            for (int i = 0; i < 2; ++i) o[h][i] = (unsigned)((u.pm * BM + h * HALF + R[i]) * lda + C[i]) * 2u; }
    __device__ __forceinline__ const char* b_ptr(const Unit& u, int t) const { return Bt + (size_t)u.pn * BM * ldb_ * 2 + (size_t)t * 128; }
};
}

struct EpiProj { static constexpr bool PERM = true; bf16_t* proj; const float* rstd;
    __device__ __forceinline__ void operator()(const f32x4 (&acc)[2][2][4][2], const pg8::DUnit& u, int wr, int wc, int fr, int fq) const {
        const int row0 = u.pm * 256 + wr * 64 + fr, col0 = u.pn * 256 + wc * 32 + 8 * fq; const float sc = (u.pn == 0) ? 0.125f : 1.0f;
        float sv[2][4];
#pragma unroll
        for (int ai = 0; ai < 2; ++ai)
#pragma unroll
            for (int m = 0; m < 4; ++m) sv[ai][m] = rstd[row0 + ai * 128 + m * 16];
#pragma unroll
        for (int ai = 0; ai < 2; ++ai)
#pragma unroll
            for (int m = 0; m < 4; ++m) { const int row = row0 + ai * 128 + m * 16; const float s = sv[ai][m] * sc; bf16_t* rp = proj + (size_t)row * NPROJ + col0;
#pragma unroll
                for (int bj = 0; bj < 2; ++bj) *(u32x4*)(rp + bj * 128) = pack8(acc[ai][bj][m][0] * s, acc[ai][bj][m][1] * s); } } };
constexpr int LROW = 72;
__device__ __forceinline__ void phase_gla_a(const Ptrs& P, LAS unsigned char* lds, int tid) {
    const int lane = tid & 63, wid = tid >> 6, fr = lane & 15, fq = lane >> 4, d = lane, tg = wid;
    LAS float* s_alow = (LAS float*)lds;
    LAS float* s_tot = (LAS float*)(lds + 4096);
    LAS bf16_t* s_kd = (LAS bf16_t*)(lds + 8192);
    LAS bf16_t* s_vt = (LAS bf16_t*)(lds + 8192 + 64 * LROW * 2);
    bf16_t* proj = (bf16_t*)(P.ws + WS_PROJ); const float* alow = (const float*)(P.ws + WS_ALOW); float* sloc = (float*)(P.ws + WS_RB); float* dec = (float*)(P.ws + WS_DEC);
    for (int item = blockIdx.x; item < NB * H * (S / 64); item += gridDim.x) {
        const int bh = item >> 7, c = item & 127, b = bh >> 2, h = bh & 3; const size_t tok0 = (size_t)b * S + (size_t)c * 64;
        float wg[LR];
#pragma unroll
        for (int r = 0; r < LR; ++r) wg[r] = P.w_gla_gate[r * QK + h * DK + d];
        const float bg = P.b_gla_gate[h * DK + d];
        for (int i = tid; i < 64 * LR; i += NTHREADS) s_alow[i] = alow[tok0 * LR + i];
        float kv[8], qv[8];
#pragma unroll
        for (int j = 0; j < 8; ++j) { const size_t m = tok0 + tg * 8 + j; kv[j] = bf2f(proj[m * NPROJ + PK + h * DK + d]); qv[j] = bf2f(proj[m * NPROJ + PQ + h * DK + d]); }
        u32x4 vv[2];
#pragma unroll
        for (int i = 0; i < 2; ++i) { const int id = tid + i * NTHREADS; vv[i] = *(const u32x4*)(proj + (tok0 + (id >> 4)) * NPROJ + PV + h * DV + (id & 15) * 8); }
        __syncthreads();
        float cum[8]; float run = 0.f;
#pragma unroll
        for (int j = 0; j < 8; ++j) { const int t = tg * 8 + j; float z = bg;
#pragma unroll
            for (int r = 0; r < LR; ++r) z += s_alow[t * LR + r] * wg[r];
            run += logsigmoidf_(z) * (1.f / 16.f); cum[j] = run; }
        s_tot[tg * 64 + d] = run;
        __syncthreads();
        float pre = 0.f, last = 0.f;
#pragma unroll
        for (int g = 0; g < 8; ++g) { const float v = s_tot[g * 64 + d]; last += v; if (g < tg) pre += v; }
#pragma unroll
        for (int j = 0; j < 8; ++j) { const int t = tg * 8 + j; const size_t m = tok0 + t; const float cm = cum[j] + pre;
            proj[m * NPROJ + PQ + h * DK + d] = f2bf(qv[j] * __expf(cm)); proj[m * NPROJ + PK + h * DK + d] = f2bf(kv[j] * __expf(-cm));
            s_kd[d * LROW + t] = f2bf(kv[j] * __expf(last - cm)); }
#pragma unroll
        for (int i = 0; i < 2; ++i) { const int id = tid + i * NTHREADS, t = id >> 4, e0 = (id & 15) * 8;
            s_vt[(e0 + 0) * LROW + t] = (bf16_t)(vv[i].x & 0xffffu); s_vt[(e0 + 1) * LROW + t] = (bf16_t)(vv[i].x >> 16);
            s_vt[(e0 + 2) * LROW + t] = (bf16_t)(vv[i].y & 0xffffu); s_vt[(e0 + 3) * LROW + t] = (bf16_t)(vv[i].y >> 16);
            s_vt[(e0 + 4) * LROW + t] = (bf16_t)(vv[i].z & 0xffffu); s_vt[(e0 + 5) * LROW + t] = (bf16_t)(vv[i].z >> 16);
            s_vt[(e0 + 6) * LROW + t] = (bf16_t)(vv[i].w & 0xffffu); s_vt[(e0 + 7) * LROW + t] = (bf16_t)(vv[i].w >> 16); }
        if (tg == 0) dec[(size_t)item * DK + d] = __expf(last);
        __syncthreads();
#pragma unroll
        for (int dt = 0; dt < 4; ++dt) { f32x4 acc = (f32x4){0.f, 0.f, 0.f, 0.f};
#pragma unroll
            for (int kk = 0; kk < 2; ++kk) { const bf16x8 a = *(const LAS bf16x8*)(s_kd + (dt * 16 + fr) * LROW + kk * 32 + fq * 8), bq = *(const LAS bf16x8*)(s_vt + (wid * 16 + fr) * LROW + kk * 32 + fq * 8);
                acc = __builtin_amdgcn_mfma_f32_16x16x32_bf16(a, bq, acc, 0, 0, 0); }
            *(f32x4*)(sloc + (size_t)item * (DK * DV) + (size_t)(wid * 16 + fr) * DK + dt * 16 + 4 * fq) = acc; }
        __syncthreads();
    }
}
__device__ __forceinline__ void phase_gla_b(const Ptrs& P, int tid) {
    const int nb_scan = gridDim.x / 2;
    if ((int)blockIdx.x < nb_scan) {
        const float* sloc = (const float*)(P.ws + WS_RB); const float* dec = (const float*)(P.ws + WS_DEC); bf16_t* st = (bf16_t*)(P.ws + WS_ST);
        for (int gt = blockIdx.x * NTHREADS + tid; gt < NB * H * DK * DV; gt += nb_scan * NTHREADS) {
            const int bh = gt >> 13, idx = gt & 8191, d = idx & 63; float sv = 0.f;
#pragma unroll 8
            for (int c = 0; c < S / 64; ++c) { const size_t item = (size_t)bh * (S / 64) + c;
                st[item * (DK * DV) + idx] = f2bf(sv); sv = dec[item * DK + d] * sv + sloc[item * (DK * DV) + idx]; }
        }
    } else {
        const bf16_t* proj = (const bf16_t*)(P.ws + WS_PROJ); bf16_t* y = (bf16_t*)(P.ws + WS_Y);
        const int nth = (gridDim.x - nb_scan) * NTHREADS;
        for (int id = (blockIdx.x - nb_scan) * NTHREADS + tid; id < T * (CW / 8); id += nth) {
            const int tok = id >> 6, c0 = (id & 63) * 8, t = tok & (S - 1);
            f32x4 a0 = (f32x4){0.f, 0.f, 0.f, 0.f}, a1 = a0;
#pragma unroll
            for (int j = 0; j < 3; ++j) { if (t - 2 + j >= 0) { const size_t mm = (size_t)tok - 2 + j; f32x4 c_0, c_1, u_0, u_1;
                unpack8(*(const u32x4*)(proj + mm * NPROJ + PC + c0), c_0, c_1); unpack8(*(const u32x4*)(proj + mm * NPROJ + PU + c0), u_0, u_1);
                const f32x4 w0 = *(const f32x4*)(P.w_conv + j * CW + c0), w1 = *(const f32x4*)(P.w_conv + j * CW + c0 + 4);
                a0 += w0 * (c_0 * u_0); a1 += w1 * (c_1 * u_1); } }
            f32x4 b0, b1; unpack8(*(const u32x4*)(proj + (size_t)tok * NPROJ + PB + c0), b0, b1);
            *(u32x4*)(y + (size_t)tok * D + GV + c0) = pack8(b0 * a0, b1 * a1);
        }
    }
}
__device__ __forceinline__ void phase_gla_c(const Ptrs& P, LAS unsigned char* lds, int tid) {
    const int lane = tid & 63, wid = tid >> 6, fr = lane & 15, fq = lane >> 4;
    LAS bf16_t* s_q = (LAS bf16_t*)lds;
    LAS bf16_t* s_k = (LAS bf16_t*)(lds + 9216);
    LAS bf16_t* s_vt = (LAS bf16_t*)(lds + 18432);
    LAS bf16_t* s_st = (LAS bf16_t*)(lds + 36864);
    LAS bf16_t* s_p = (LAS bf16_t*)(lds + 55296);
    LAS float* s_red = (LAS float*)(lds + 64512);
    const bf16_t* proj = (const bf16_t*)(P.ws + WS_PROJ); const bf16_t* st = (const bf16_t*)(P.ws + WS_ST); bf16_t* y = (bf16_t*)(P.ws + WS_Y);
    const int tt = wid >> 1, wh = wid & 1;
    for (int item = blockIdx.x; item < NB * H * (S / 64); item += gridDim.x) {
        const int bh = item >> 7, c = item & 127, b = bh >> 2, h = bh & 3; const size_t tok0 = (size_t)b * S + (size_t)c * 64;
        { const int row = tid >> 3, ch = tid & 7;
          *(LAS u32x4*)(s_q + row * LROW + ch * 8) = *(const u32x4*)(proj + (tok0 + row) * NPROJ + PQ + h * DK + ch * 8);
          *(LAS u32x4*)(s_k + row * LROW + ch * 8) = *(const u32x4*)(proj + (tok0 + row) * NPROJ + PK + h * DK + ch * 8); }
#pragma unroll
        for (int i = 0; i < 2; ++i) { const int id = tid + i * NTHREADS, row = id >> 3, ch = id & 7;
            *(LAS u32x4*)(s_st + row * LROW + ch * 8) = *(const u32x4*)(st + (size_t)item * (DK * DV) + row * DK + ch * 8); }
#pragma unroll
        for (int i = 0; i < 2; ++i) { const int id = tid + i * NTHREADS, t = id >> 4, e0 = (id & 15) * 8;
            const u32x4 vv = *(const u32x4*)(proj + (tok0 + t) * NPROJ + PV + h * DV + e0);
            s_vt[(e0 + 0) * LROW + t] = (bf16_t)(vv.x & 0xffffu); s_vt[(e0 + 1) * LROW + t] = (bf16_t)(vv.x >> 16);
            s_vt[(e0 + 2) * LROW + t] = (bf16_t)(vv.y & 0xffffu); s_vt[(e0 + 3) * LROW + t] = (bf16_t)(vv.y >> 16);
            s_vt[(e0 + 4) * LROW + t] = (bf16_t)(vv.z & 0xffffu); s_vt[(e0 + 5) * LROW + t] = (bf16_t)(vv.z >> 16);
            s_vt[(e0 + 6) * LROW + t] = (bf16_t)(vv.w & 0xffffu); s_vt[(e0 + 7) * LROW + t] = (bf16_t)(vv.w >> 16); }
        __syncthreads();
#pragma unroll
        for (int si = 0; si < 2; ++si) { const int stile = wh * 2 + si; f32x4 acc = (f32x4){0.f, 0.f, 0.f, 0.f};
#pragma unroll
            for (int kk = 0; kk < 2; ++kk) { const bf16x8 a = *(const LAS bf16x8*)(s_k + (stile * 16 + fr) * LROW + kk * 32 + fq * 8), bq = *(const LAS bf16x8*)(s_q + (tt * 16 + fr) * LROW + kk * 32 + fq * 8);
                acc = __builtin_amdgcn_mfma_f32_16x16x32_bf16(a, bq, acc, 0, 0, 0); }
            const int t = tt * 16 + fr, s0 = stile * 16 + 4 * fq;
            u32x2 w; w.x = pk2(s0 + 0 <= t ? acc[0] : 0.f, s0 + 1 <= t ? acc[1] : 0.f); w.y = pk2(s0 + 2 <= t ? acc[2] : 0.f, s0 + 3 <= t ? acc[3] : 0.f);
            *(LAS u32x2*)(s_p + t * LROW + s0) = w; }
        __syncthreads();
        f32x4 o[4]; float sq = 0.f;
#pragma unroll
        for (int ei = 0; ei < 4; ++ei) { const int et = wh * 4 + ei; f32x4 acc = (f32x4){0.f, 0.f, 0.f, 0.f};
#pragma unroll
            for (int kk = 0; kk < 2; ++kk) { const bf16x8 a = *(const LAS bf16x8*)(s_st + (et * 16 + fr) * LROW + kk * 32 + fq * 8), bq = *(const LAS bf16x8*)(s_q + (tt * 16 + fr) * LROW + kk * 32 + fq * 8);
                acc = __builtin_amdgcn_mfma_f32_16x16x32_bf16(a, bq, acc, 0, 0, 0); }
#pragma unroll
            for (int kk = 0; kk < 2; ++kk) { const bf16x8 a = *(const LAS bf16x8*)(s_vt + (et * 16 + fr) * LROW + kk * 32 + fq * 8), bq = *(const LAS bf16x8*)(s_p + (tt * 16 + fr) * LROW + kk * 32 + fq * 8);
                acc = __builtin_amdgcn_mfma_f32_16x16x32_bf16(a, bq, acc, 0, 0, 0); }
            o[ei] = acc; sq += sq4(acc); }
        sq += __shfl_xor(sq, 16); sq += __shfl_xor(sq, 32);
        const int t = tt * 16 + fr;
        if (fq == 0) s_red[t * 2 + wh] = sq;
        __syncthreads();
        const float rstd = rsqrtf((s_red[t * 2] + s_red[t * 2 + 1]) * (1.f / DV) + EPS);
#pragma unroll
        for (int ei = 0; ei < 4; ++ei) { const int e0 = (wh * 4 + ei) * 16 + 4 * fq;
            const u32x2 gw = *(const u32x2*)(proj + (tok0 + t) * NPROJ + PG + h * DV + e0); const f32x4 gg = *(const f32x4*)(P.g_gla_out + e0);
            const float g0 = __uint_as_float(gw.x << 16), g1 = __uint_as_float(gw.x & 0xffff0000u), g2 = __uint_as_float(gw.y << 16), g3 = __uint_as_float(gw.y & 0xffff0000u);
            u32x2 w; w.x = pk2(o[ei][0] * rstd * gg[0] * siluf_(g0), o[ei][1] * rstd * gg[1] * siluf_(g1)); w.y = pk2(o[ei][2] * rstd * gg[2] * siluf_(g2), o[ei][3] * rstd * gg[3] * siluf_(g3));
            *(u32x2*)(y + (tok0 + t) * D + h * DV + e0) = w; }
        __syncthreads();
    }
}
struct EpiOut { static constexpr bool PERM = true; const float* x; bf16_t* x1; float* ssq; LAS float* s_part;
    __device__ __forceinline__ void operator()(const f32x4 (&acc)[2][2][4][2], const pg8::DUnit& u, int wr, int wc, int fr, int fq) const {
        const int row0 = u.pm * 256 + wr * 64 + fr, col0 = u.pn * 256 + wc * 32 + 8 * fq; float sq[2][4];
#pragma unroll
        for (int ai = 0; ai < 2; ++ai)
#pragma unroll
            for (int mh = 0; mh < 2; ++mh) { f32x4 xv[2][2][2];
#pragma unroll
                for (int mm = 0; mm < 2; ++mm) { const size_t off = (size_t)(row0 + ai * 128 + (mh * 2 + mm) * 16) * D + col0;
#pragma unroll
                    for (int bj = 0; bj < 2; ++bj) { xv[mm][bj][0] = *(const f32x4*)(x + off + bj * 128); xv[mm][bj][1] = *(const f32x4*)(x + off + bj * 128 + 4); } }
#pragma unroll
                for (int mm = 0; mm < 2; ++mm) { const int m = mh * 2 + mm; const size_t off = (size_t)(row0 + ai * 128 + m * 16) * D + col0; float q = 0.f;
#pragma unroll
                    for (int bj = 0; bj < 2; ++bj) { const f32x4 r0 = xv[mm][bj][0] + acc[ai][bj][m][0], r1 = xv[mm][bj][1] + acc[ai][bj][m][1]; q += sq4(r0) + sq4(r1); *(u32x4*)(x1 + off + bj * 128) = pack8(r0, r1); }
                    sq[ai][m] = q; }
                asm volatile("" ::: "memory"); }
        const float tot = ssq_unit_rows(s_part, sq, wr, wc, fr, fq);
        if (threadIdx.x < 256) ssq[(size_t)(u.pm * 256 + threadIdx.x) * 4 + u.pn] = tot; } };
__device__ __forceinline__ void phase_route(const Ptrs& P, LAS unsigned char* lds, int tid) {
    const int lane = tid & 63, wid = tid >> 6, fr = lane & 15, fq = lane >> 4, tl = wid >> 1, kh = wid & 1;
    const bf16_t* x1 = (const bf16_t*)(P.ws + WS_RB); const bf16_t* WRh = (const bf16_t*)(P.ws + WS_WR); const bf16_t* WRl = WRh + 32 * D; const float* ssq2 = (const float*)(P.ws + WS_SSQ2);
    TokInfo* ti = (TokInfo*)(P.ws + WS_TOKI); int* lists = (int*)(P.ws + WS_LIST); unsigned* cnt = (unsigned*)(P.ws + WS_CTL);
    LAS float* s_lg = (LAS float*)lds;
    LAS unsigned* s_cnt = (LAS unsigned*)(lds + 8 * 16 * 33 * 4); LAS unsigned* s_base = s_cnt + 32;
    for (int tb = blockIdx.x * 4; tb < T / 16; tb += gridDim.x * 4) {
        const int tok0 = (tb + tl) * 16;
        f32x4 acc0 = (f32x4){0.f, 0.f, 0.f, 0.f}, acc1 = acc0;
#pragma unroll 4
        for (int ks = 0; ks < D / 64; ++ks) { const int ko = kh * (D / 2) + ks * 32 + fq * 8;
            const bf16x8 a = *(const bf16x8*)(x1 + (size_t)(tok0 + fr) * D + ko);
            const bf16x8 h0 = *(const bf16x8*)(WRh + fr * D + ko), h1 = *(const bf16x8*)(WRh + (16 + fr) * D + ko), l0 = *(const bf16x8*)(WRl + fr * D + ko), l1 = *(const bf16x8*)(WRl + (16 + fr) * D + ko);
            acc0 = __builtin_amdgcn_mfma_f32_16x16x32_bf16(a, h0, acc0, 0, 0, 0); acc0 = __builtin_amdgcn_mfma_f32_16x16x32_bf16(a, l0, acc0, 0, 0, 0);
            acc1 = __builtin_amdgcn_mfma_f32_16x16x32_bf16(a, h1, acc1, 0, 0, 0); acc1 = __builtin_amdgcn_mfma_f32_16x16x32_bf16(a, l1, acc1, 0, 0, 0); }
        LAS float* mine = s_lg + wid * (16 * 33);
#pragma unroll
        for (int r = 0; r < 4; ++r) { mine[(4 * fq + r) * 33 + fr] = acc0[r]; mine[(4 * fq + r) * 33 + 16 + fr] = acc1[r]; }
        if (tid < NCAT) s_cnt[tid] = 0u;
        __syncthreads();
        int my_cat = 0, my_tok = 0; unsigned my_local = 0u;
        if (tid < 64) {
            const int m = (tb + (tid >> 4)) * 16 + (tid & 15); const LAS float* lg0 = s_lg + ((tid >> 4) * 2) * (16 * 33) + (tid & 15) * 33; const LAS float* lg1 = lg0 + 16 * 33;
            const float rstd = rstd_from_parts(ssq2, m);
            float gl[4]; int gs = 0;
#pragma unroll
            for (int j = 0; j < 4; ++j) gl[j] = (lg0[j] + lg1[j]) * rstd + P.b_group[j];
            float gbest = gl[0];
#pragma unroll
            for (int j = 1; j < 4; ++j) if (gl[j] > gbest) { gbest = gl[j]; gs = j; }
            float den = 0.f;
#pragma unroll
            for (int j = 0; j < 4; ++j) den += __expf(gl[j] - gbest);
            const float pgrp = 1.f / den;
            float el[4];
#pragma unroll
            for (int j = 0; j < 4; ++j) el[j] = (lg0[4 + gs * 4 + j] + lg1[4 + gs * 4 + j]) * rstd + P.b_router[gs * 4 + j];
            int i0 = 0; float v0 = el[0];
#pragma unroll
            for (int j = 1; j < 4; ++j) if (el[j] > v0) { v0 = el[j]; i0 = j; }
            int i1 = -1; float v1 = -3.0e38f;
#pragma unroll
            for (int j = 0; j < 4; ++j) if (j != i0 && el[j] > v1) { v1 = el[j]; i1 = j; }
            const float e1 = __expf(v1 - v0);
            const float w0 = pgrp / (1.f + e1), w1 = pgrp * e1 / (1.f + e1);
            const int lo = i0 < i1 ? i0 : i1, hi = i0 < i1 ? i1 : i0;
            const int pidx = (lo == 0) ? (hi - 1) : (lo == 1 ? (hi + 1) : 5);
            const int cat = gs * 6 + pidx;
            TokInfo info; info.cat = cat; info.w_lo = (i0 < i1) ? w0 : w1; info.w_hi = (i0 < i1) ? w1 : w0; info.rstd = rstd;
            ti[m] = info;
            my_cat = cat; my_tok = m; my_local = __hip_atomic_fetch_add(s_cnt + cat, 1u, __ATOMIC_RELAXED, __HIP_MEMORY_SCOPE_WORKGROUP);
        }
        __syncthreads();
        if (tid < NCAT) { const unsigned c = s_cnt[tid]; if (c) s_base[tid] = atomicAdd(cnt + tid, c); }
        __syncthreads();
        if (tid < 64) lists[(size_t)my_cat * T + s_base[my_cat] + my_local] = my_tok;
        __syncthreads();
    }
}
__device__ __forceinline__ void cat_experts(int cat, int& e_lo, int& e_hi) {
    const int g = cat / 6, p = cat % 6; int lo, hi;
    if (p < 3) { lo = 0; hi = p + 1; } else if (p < 5) { lo = 1; hi = p - 1; } else { lo = 2; hi = 3; }
    e_lo = g * 4 + lo; e_hi = g * 4 + hi;
}
__device__ __forceinline__ bool rowtile_lookup(const unsigned* cnt, int rt, int& cat, int& slot0, int& n) {
    int base = 0;
    for (int c = 0; c < NCAT; ++c) { const int nc = (int)__hip_atomic_load(cnt + c, __ATOMIC_RELAXED, __HIP_MEMORY_SCOPE_AGENT), ntile = (nc + 255) >> 8; if (rt < base + ntile) { cat = c; slot0 = (rt - base) * 256; n = nc; return true; } base += ntile; }
    cat = 0; slot0 = 0; n = 0; return false;
}
typedef int i32x4 __attribute__((ext_vector_type(4)));
__device__ __forceinline__ void build_rt_table(const unsigned* cnt, LAS unsigned char* lds, int tid) {
    LAS i32x4* tab = (LAS i32x4*)(lds + LDS_RTT_OFF);
    if (tid <= MAXRT) { int base = 0, cat = -1, slot0 = 0, n = 0;
        for (int c = 0; c < NCAT; ++c) { const int nc = (int)__hip_atomic_load(cnt + c, __ATOMIC_RELAXED, __HIP_MEMORY_SCOPE_AGENT), ntile = (nc + 255) >> 8;
            if (cat < 0 && tid < base + ntile) { cat = c; slot0 = (tid - base) * 256; n = nc; } base += ntile; }
        tab[tid] = (tid == MAXRT) ? (i32x4){base, 0, 0, 0} : (i32x4){cat, slot0, n, 0}; }
    __syncthreads();
}
struct MUnit { int rt, pn, cat, slot0, n, e_lo, e_hi; };
struct PbMoe1 {
    typedef MUnit Unit;
    const char* X1; const char* W1; const int* lists; const LAS i32x4* tab; int G, c;
    __device__ __forceinline__ bool next(int i, Unit& u) const { const int L = i * G + c; u.rt = L >> 3; u.pn = L & 7; if (u.rt >= tab[MAXRT].x) return false;
        const i32x4 e = tab[u.rt]; u.cat = e.x; u.slot0 = e.y; u.n = e.z; cat_experts(u.cat, u.e_lo, u.e_hi); return true; }
    __device__ __forceinline__ int nt() const { return D / 64; }
    __device__ __forceinline__ const char* a_base() const { return X1; }
    __device__ __forceinline__ unsigned ldb() const { return (unsigned)D; }
    __device__ __forceinline__ void a_offs(const Unit& u, const int (&R)[2], const int (&C)[2], unsigned (&o)[2][2]) const {
        const int* list = lists + (size_t)u.cat * T;
#pragma unroll
        for (int h = 0; h < 2; ++h)
#pragma unroll
            for (int i = 0; i < 2; ++i) { int sl = u.slot0 + h * 128 + R[i]; if (sl >= u.n) sl = u.slot0; o[h][i] = (unsigned)(list[sl] * D + C[i]) * 2u; } }
    __device__ __forceinline__ const char* b_ptr(const Unit& u, int t) const { const int e = (u.pn >> 2) ? u.e_hi : u.e_lo; return W1 + ((size_t)e * D + (size_t)(u.pn & 3) * 256) * D * 2 + (size_t)t * 128; }
};
struct EpiHid { static constexpr bool PERM = true; bf16_t* hid; const TokInfo* ti; const int* lists;
    __device__ __forceinline__ void operator()(const f32x4 (&acc)[2][2][4][2], const MUnit& u, int wr, int wc, int fr, int fq) const {
        const int* list = lists + (size_t)u.cat * T; const int kx = u.pn >> 2, col0 = kx * 512 + (u.pn & 3) * 128 + wc * 32 + 8 * fq;
#pragma unroll
        for (int ai = 0; ai < 2; ++ai)
#pragma unroll
            for (int m = 0; m < 4; ++m) { const int rl = ai * 128 + wr * 64 + m * 16 + fr, sl = u.slot0 + rl;
                if (sl < u.n) { const TokInfo t = ti[list[sl]]; const float w = kx ? t.w_hi : t.w_lo; f32x4 o[2];
#pragma unroll
                    for (int n = 0; n < 2; ++n)
#pragma unroll
                        for (int j = 0; j < 4; ++j) { const float g = acc[ai][0][m][n][j] * t.rstd, up = acc[ai][1][m][n][j] * t.rstd; o[n][j] = siluf_(g) * up * w; }
                    *(u32x4*)(hid + (size_t)(u.rt * 256 + rl) * D + col0) = pack8(o[0], o[1]); } } } };
__device__ __forceinline__ void phase_moe1(const Ptrs& P, LAS unsigned char* lds) {
    PbMoe1 pb{(const char*)(P.ws + WS_RB), (const char*)(P.ws + WS_W1), (const int*)(P.ws + WS_LIST), (const LAS i32x4*)(lds + LDS_RTT_OFF), (int)gridDim.x, (int)blockIdx.x};
    EpiHid ep{(bf16_t*)(P.ws + WS_HID), (const TokInfo*)(P.ws + WS_TOKI), (const int*)(P.ws + WS_LIST)};
    pg8::gemm_phase<PbMoe1, EpiHid, true>(lds, pb, ep);
}
struct PbMoe2 {
    typedef MUnit Unit;
    const char* HID; const char* W2; const LAS i32x4* tab; int G, c;
    __device__ __forceinline__ bool next(int i, Unit& u) const { const int L = i * G + c; u.rt = L >> 2; u.pn = L & 3; if (u.rt >= tab[MAXRT].x) return false;
        const i32x4 e = tab[u.rt]; u.cat = e.x; u.slot0 = e.y; u.n = e.z; cat_experts(u.cat, u.e_lo, u.e_hi); return true; }
    __device__ __forceinline__ int nt() const { return D / 64; }
    __device__ __forceinline__ const char* a_base() const { return HID; }
    __device__ __forceinline__ unsigned ldb() const { return 2048u; }
    __device__ __forceinline__ void a_offs(const Unit& u, const int (&R)[2], const int (&C)[2], unsigned (&o)[2][2]) const {
#pragma unroll
        for (int h = 0; h < 2; ++h)
#pragma unroll
            for (int i = 0; i < 2; ++i) o[h][i] = (unsigned)((u.rt * 256 + h * 128 + R[i]) * D + C[i]) * 2u; }
    __device__ __forceinline__ const char* b_ptr(const Unit& u, int t) const {
        const int g = u.e_lo >> 2, el = (t < 8) ? (u.e_lo & 3) : (u.e_hi & 3);
        return W2 + ((size_t)g * D + (size_t)u.pn * 256) * 2048 * 2 + (size_t)el * 1024 + (size_t)(t & 7) * 128; }
};
struct EpiX2 { static constexpr bool PERM = true; const bf16_t* x1; bf16_t* x2; float* ssq; const int* lists; LAS float* s_part;
    __device__ __forceinline__ void operator()(const f32x4 (&acc)[2][2][4][2], const MUnit& u, int wr, int wc, int fr, int fq) const {
        const int* list = lists + (size_t)u.cat * T; const int col0 = u.pn * 256 + wc * 32 + 8 * fq; float sq[2][4];
#pragma unroll
        for (int ai = 0; ai < 2; ++ai) { int tok[4];
#pragma unroll
            for (int m = 0; m < 4; ++m) { const int sl = u.slot0 + ai * 128 + wr * 64 + m * 16 + fr; tok[m] = list[sl < u.n ? sl : u.slot0]; }
#pragma unroll
            for (int mh = 0; mh < 2; ++mh) { u32x4 xv[2][2];
#pragma unroll
                for (int mm = 0; mm < 2; ++mm)
#pragma unroll
                    for (int bj = 0; bj < 2; ++bj) xv[mm][bj] = *(const u32x4*)(x1 + (size_t)tok[mh * 2 + mm] * D + col0 + bj * 128);
#pragma unroll
                for (int mm = 0; mm < 2; ++mm) { const int m = mh * 2 + mm; const bool v = (u.slot0 + ai * 128 + wr * 64 + m * 16 + fr) < u.n; const size_t off = (size_t)tok[m] * D + col0; float q = 0.f;
#pragma unroll
                    for (int bj = 0; bj < 2; ++bj) { f32x4 r0, r1; unpack8(xv[mm][bj], r0, r1); r0 += acc[ai][bj][m][0]; r1 += acc[ai][bj][m][1]; q += sq4(r0) + sq4(r1); if (v) *(u32x4*)(x2 + off + bj * 128) = pack8(r0, r1); }
                    sq[ai][m] = q; }
                asm volatile("" ::: "memory"); } }
        const float tot = ssq_unit_rows(s_part, sq, wr, wc, fr, fq);
        if (threadIdx.x < 256) { const int sl = u.slot0 + (int)threadIdx.x; if (sl < u.n) ssq[(size_t)list[sl] * 4 + u.pn] = tot; } } };
__device__ __forceinline__ void phase_moe2(const Ptrs& P, LAS unsigned char* lds) {
    PbMoe2 pb{(const char*)(P.ws + WS_HID), (const char*)(P.ws + WS_W2), (const LAS i32x4*)(lds + LDS_RTT_OFF), (int)gridDim.x, (int)blockIdx.x};
    EpiX2 ep{(const bf16_t*)(P.ws + WS_RB), (bf16_t*)(P.ws + WS_X2), (float*)(P.ws + WS_SSQ3), (const int*)(P.ws + WS_LIST), (LAS float*)(lds + LDS_PART_OFF)};
    pg8::gemm_phase<PbMoe2, EpiX2, true>(lds, pb, ep);
}
struct EpiPP { static constexpr bool PERM = true; bf16_t* pp;
    __device__ __forceinline__ void operator()(const f32x4 (&acc)[2][2][4][2], const pg8::DUnit& u, int wr, int wc, int fr, int fq) const {
        const int row0 = u.pm * 256 + wr * 64 + fr, col0 = u.pn * 256 + wc * 32 + 8 * fq;
#pragma unroll
        for (int ai = 0; ai < 2; ++ai)
#pragma unroll
            for (int m = 0; m < 4; ++m) { bf16_t* rp = pp + (size_t)(row0 + ai * 128 + m * 16) * D + col0;
#pragma unroll
                for (int bj = 0; bj < 2; ++bj) *(u32x4*)(rp + bj * 128) = pack8(acc[ai][bj][m][0], acc[ai][bj][m][1]); } } };
struct EpiPle { static constexpr bool PERM = true; const bf16_t* x2; const bf16_t* pp; const float* ssq3; bf16_t* x3; float* ssq4; LAS float* s_part;
    __device__ __forceinline__ void operator()(const f32x4 (&acc)[2][2][4][2], const pg8::DUnit& u, int wr, int wc, int fr, int fq) const {
        const int row0 = u.pm * 256 + wr * 64 + fr, col0 = u.pn * 256 + wc * 32 + 8 * fq; float sq[2][4], rs[2][4];
#pragma unroll
        for (int ai = 0; ai < 2; ++ai)
#pragma unroll
            for (int m = 0; m < 4; ++m) rs[ai][m] = rstd_from_parts(ssq3, row0 + ai * 128 + m * 16);
#pragma unroll
        for (int ai = 0; ai < 2; ++ai)
#pragma unroll
            for (int mh = 0; mh < 2; ++mh) { u32x4 xv[2][2], pv[2][2];
#pragma unroll
                for (int mm = 0; mm < 2; ++mm) { const size_t off = (size_t)(row0 + ai * 128 + (mh * 2 + mm) * 16) * D + col0;
#pragma unroll
                    for (int bj = 0; bj < 2; ++bj) { xv[mm][bj] = *(const u32x4*)(x2 + off + bj * 128); pv[mm][bj] = *(const u32x4*)(pp + off + bj * 128); } }
#pragma unroll
                for (int mm = 0; mm < 2; ++mm) { const int m = mh * 2 + mm; const size_t off = (size_t)(row0 + ai * 128 + m * 16) * D + col0; const float rstd = rs[ai][m]; float q = 0.f;
#pragma unroll
                    for (int bj = 0; bj < 2; ++bj) { f32x4 a0, a1, p0, p1; unpack8(xv[mm][bj], a0, a1); unpack8(pv[mm][bj], p0, p1);
#pragma unroll
                        for (int j = 0; j < 4; ++j) { a0[j] += sigmoidf_(acc[ai][bj][m][0][j] * rstd) * p0[j]; a1[j] += sigmoidf_(acc[ai][bj][m][1][j] * rstd) * p1[j]; }
                        q += sq4(a0) + sq4(a1); *(u32x4*)(x3 + off + bj * 128) = pack8(a0, a1); }
                    sq[ai][m] = q; }
                asm volatile("" ::: "memory"); }
        const float tot = ssq_unit_rows(s_part, sq, wr, wc, fr, fq);
        if (threadIdx.x < 256) ssq4[(size_t)(u.pm * 256 + threadIdx.x) * 4 + u.pn] = tot; } };
__device__ __forceinline__ void phase_final(const Ptrs& P, int tid) {
    const int lane = tid & 63, gw = blockIdx.x * 8 + (tid >> 6), ngw = gridDim.x * 8;
    const bf16_t* x3 = (const bf16_t*)(P.ws + WS_X3); const float* ssq4 = (const float*)(P.ws + WS_SSQ4);
    f32x4 g[4];
#pragma unroll
    for (int j = 0; j < 2; ++j) { g[2 * j] = *(const f32x4*)(P.g_final + 512 * j + 8 * lane); g[2 * j + 1] = *(const f32x4*)(P.g_final + 512 * j + 8 * lane + 4); }
    for (int m = gw; m < T; m += ngw) {
        const float rstd = rstd_from_parts(ssq4, m);
#pragma unroll
        for (int j = 0; j < 2; ++j) { f32x4 a0, a1; unpack8(*(const u32x4*)(x3 + (size_t)m * D + 512 * j + 8 * lane), a0, a1);
            float* op = P.out + (size_t)m * D + 512 * j + 8 * lane; *(f32x4*)op = a0 * rstd * g[2 * j]; *(f32x4*)(op + 4) = a1 * rstd * g[2 * j + 1]; }
    }
}
__global__ void __launch_bounds__(NTHREADS, 2) mega_fwd(Ptrs P) {
    extern __shared__ __attribute__((aligned(16))) unsigned char lds_raw[];
    LAS unsigned char* lds = (LAS unsigned char*)lds_raw;
    const int tid = threadIdx.x;
    LAS unsigned* lctl = (LAS unsigned*)(lds + LDSCTL_OFF);
    for (int u = tid; u < 64; u += NTHREADS) lctl[u] = 0u;
    __syncthreads();
    XcdBarrier bar = xcd_barrier_post((unsigned*)(P.ws + WS_CTL) + CW_BAR, (volatile LAS unsigned*)(lctl + 8));

#define PH(n) for (int _r = 0; _r < 1 + ((PROBE_DUP == (n)) ? PROBE_REP : 0); ++_r)
    PH(0) phase_prep(P, lds, opq(tid));
    xcd_barrier(bar);
    PH(1) { pg8::PbDense pb; pb.init(P.ws + WS_RB, D, P.ws + WS_WIN, D, T, NPROJ, D); EpiProj ep{(bf16_t*)(P.ws + WS_PROJ), (const float*)(P.ws + WS_RSTD1)};
      pg8::gemm_phase<pg8::PbDense, EpiProj, true>(lds, pb, ep); }
    xcd_barrier(bar);
    phase_gla_a(P, lds, opq(tid));
    xcd_barrier(bar);
    PH(3) phase_gla_b(P, opq(tid));
    xcd_barrier(bar);
    PH(4) phase_gla_c(P, lds, opq(tid));
    xcd_barrier(bar);
    PH(5) { pg8::PbDense pb; pb.init(P.ws + WS_Y, D, P.ws + WS_WOUT, D, T, D, D); EpiOut ep{P.x, (bf16_t*)(P.ws + WS_RB), (float*)(P.ws + WS_SSQ2), (LAS float*)(lds + LDS_PART_OFF)};
      pg8::gemm_phase<pg8::PbDense, EpiOut, true>(lds, pb, ep); }
    xcd_barrier(bar);
    phase_route(P, lds, opq(tid));
    xcd_barrier(bar);
    build_rt_table((const unsigned*)(P.ws + WS_CTL), lds, opq(tid));
    PH(7) { phase_moe1(P, lds);
      { pg8::PbDense pb; pb.init(P.ws + WS_PB, DPLE, P.ws + WS_WPP, DPLE, T, D, DPLE); EpiPP ep{(bf16_t*)(P.ws + WS_Y)};
        pg8::gemm_phase<pg8::PbDense, EpiPP, true>(lds, pb, ep); } }
    xcd_barrier(bar);
    PH(8) phase_moe2(P, lds);
    xcd_barrier(bar);
    PH(9) { pg8::PbDense pb; pb.init(P.ws + WS_X2, D, P.ws + WS_WPG, D, T, D, D);
      EpiPle ep{(const bf16_t*)(P.ws + WS_X2), (const bf16_t*)(P.ws + WS_Y), (const float*)(P.ws + WS_SSQ3), (bf16_t*)(P.ws + WS_X3), (float*)(P.ws + WS_SSQ4), (LAS float*)(lds + LDS_PART_OFF)};
      pg8::gemm_phase<pg8::PbDense, EpiPle, true>(lds, pb, ep); }
    xcd_barrier(bar);
    PH(10) phase_final(P, opq(tid));
    if (PROBE_DUP == 11) for (int _r = 0; _r < 10; ++_r) xcd_barrier(bar);
#undef PH
}

extern "C" void kernel_launch(void* const* d_in, const int* in_sizes, int n_in, void* d_out, int out_size, void* d_ws, size_t ws_size, hipStream_t stream) {
    static int grid = 0;
    if (grid == 0) {
        if (n_in != 21 || in_sizes[0] != T * D || out_size != T * D || ws_size < WS_END) {
            fprintf(stderr, "kernel_launch: unexpected shapes: n_in %d in0 %d out %d ws %zu\n", n_in, n_in > 0 ? in_sizes[0] : -1, out_size, ws_size); grid = -1; return; }
        int dev = 0, cus = 0, per_cu = 0;
        if (hipGetDevice(&dev) != hipSuccess || hipDeviceGetAttribute(&cus, hipDeviceAttributeMultiprocessorCount, dev) != hipSuccess) { grid = -1; return; }
        if (hipFuncSetAttribute((const void*)mega_fwd, hipFuncAttributeMaxDynamicSharedMemorySize, LDS_BYTES) != hipSuccess) { fprintf(stderr, "kernel_launch: hipFuncSetAttribute failed\n"); grid = -1; return; }
        if (hipOccupancyMaxActiveBlocksPerMultiprocessor(&per_cu, (const void*)mega_fwd, NTHREADS, LDS_BYTES) != hipSuccess || per_cu < 1) {
            fprintf(stderr, "kernel_launch: occupancy query says %d workgroups per CU; not launching\n", per_cu); grid = -1; return; }
        (void)hipGetLastError();
        grid = cus;
    }
    if (grid < 0) return;
    Ptrs P{};
    const float** pp = (const float**)&P;
    for (int i = 0; i < 21; ++i) pp[i] = (const float*)d_in[i];
    P.out = (float*)d_out; P.ws = (unsigned char*)d_ws;
    if (hipMemsetAsync((char*)d_ws + WS_CTL, 0, CTL_BYTES, stream) != hipSuccess) { fprintf(stderr, "kernel_launch: memset failed\n"); return; }
    hipLaunchKernelGGL(mega_fwd, dim3(grid), dim3(NTHREADS), LDS_BYTES, stream, P);
}
```
